# Optimizing an MI355X kernel written in HIP

```python
import math
import jax, jax.numpy as jnp
from jax import lax
import numpy as np

D_MODEL = 1024
BATCH = 4
SEQ = 8192
DEPTH = 4

CHUNK = 64
N_META = 16
PAD_FRONT = 128 - N_META
Q_BLOCK = 128
NORM_EPS = 1e-6
NEG_INF = -1e30
A_HEADS = 8
A_DIM = 64
IDX_HEADS = 8
IDX_DIM = 64
IDX_SCALE = (IDX_DIM ** -0.5) * (IDX_HEADS ** -0.5)
TOPK_MAX = 256
B_HEADS = 4
B_DK = 64
B_DV = 128
GLA_GATE_RANK = 16
GLA_TAU = 16.0
C_HEADS = 4
C_DK = 64
C_DV = 128
ROPE_BASE = 10000.0
D_HEADS = 8
D_DIM = 64
REL_BUCKETS = 32
REL_MAX_DIST = 128
SPLIT_AB = (A_HEADS * A_DIM, A_HEADS * A_DIM, A_HEADS * A_DIM, A_HEADS * A_DIM,
            IDX_HEADS * IDX_DIM, IDX_DIM, IDX_HEADS,
            B_HEADS * B_DK, B_HEADS * B_DK, B_HEADS * B_DV, B_HEADS * B_DV, GLA_GATE_RANK)
SPLIT_CD = (C_HEADS * C_DK, C_HEADS * C_DK, C_HEADS * C_DV, C_HEADS * C_DV,
            D_HEADS * D_DIM, D_HEADS * D_DIM, D_HEADS * D_DIM, D_HEADS * D_DIM)
W_AB = sum(SPLIT_AB)
W_CD = sum(SPLIT_CD)
MIX_AB = A_HEADS * A_DIM + B_HEADS * B_DV
MIX_CD = C_HEADS * C_DV + D_HEADS * D_DIM

kernel_name = 'hybrid_dsa_gla_retnet_stickbreak'


def rms_norm(x, g):
    xf = x.astype(jnp.float32)
    y = xf * lax.rsqrt(jnp.mean(xf * xf, -1, keepdims=True) + NORM_EPS)
    return (y * g.astype(jnp.float32)).astype(x.dtype)


def head_rms(o):
    return o * lax.rsqrt(jnp.mean(o * o, -1, keepdims=True) + NORM_EPS)


def head_layer_norm(o):
    o = o - jnp.mean(o, -1, keepdims=True)
    return o * lax.rsqrt(jnp.mean(o * o, -1, keepdims=True) + NORM_EPS)


def split_cols(t, sizes):
    return jnp.split(t, np.cumsum(sizes)[:-1].tolist(), axis=-1)


def rel_bucket(rel):
    half = REL_BUCKETS // 2
    max_exact = half // 2
    n = -rel
    ret = jnp.where(n < 0, half, 0)
    n = jnp.abs(n)
    nf = jnp.maximum(n, 1).astype(jnp.float32)
    large = max_exact + (jnp.log(nf / max_exact) / math.log(REL_MAX_DIST / max_exact)
                         * (half - max_exact)).astype(jnp.int32)
    large = jnp.minimum(large, half - 1)
    return ret + jnp.where(n < max_exact, n, large)


def rotary(x, pos):
    half = x.shape[-1] // 2
    inv = ROPE_BASE ** (-jnp.arange(half, dtype=jnp.float32) / half)
    ang = pos.astype(jnp.float32)[:, None] * inv[None, :]
    cos = jnp.cos(ang)[None, :, None, :]
    sin = jnp.sin(ang)[None, :, None, :]
    x1, x2 = x[..., :half], x[..., half:]
    return jnp.concatenate([x1 * cos - x2 * sin, x1 * sin + x2 * cos], -1)


def to_chunks(t):
    b, p, h, d = t.shape
    return t.reshape(b, p // CHUNK, CHUNK, h, d).transpose(0, 3, 1, 2, 4)


def from_chunks(t):
    b, h, n, c, e = t.shape
    return t.transpose(0, 2, 3, 1, 4).reshape(b, n * c, h, e)


def dsa_attention(q, k, v, iq, ik, iw, rel_bias, chunk, valid, topk):
    bsz, P, H, dh = q.shape
    take = jax.vmap(lambda t, ii: t[ii])

    def block(i):
        s0 = i * Q_BLOCK
        qb = lax.dynamic_slice_in_dim(q, s0, Q_BLOCK, axis=1)
        iqb = lax.dynamic_slice_in_dim(iq, s0, Q_BLOCK, axis=1)
        iwb = lax.dynamic_slice_in_dim(iw, s0, Q_BLOCK, axis=1)
        qpos = s0 + jnp.arange(Q_BLOCK, dtype=jnp.int32)
        qchunk = qpos // CHUNK
        adm = valid[None, :] & (chunk[None, :] <= qchunk[:, None])
        sc = jax.nn.relu(jnp.einsum('bqhd,bsd->bqhs', iqb, ik).astype(jnp.float32))
        score = jnp.einsum('bqhs,bqh->bqs', sc, iwb.astype(jnp.float32)) * IDX_SCALE
        score = jnp.where(adm[None], score, NEG_INF)
        _, idx = lax.top_k(score, topk)
        kg = take(k, idx)
        vg = take(v, idx)
        logits = jnp.einsum('bqhd,bqkhd->bhqk', qb, kg).astype(jnp.float32) * dh ** -0.5
        bias = rel_bias[rel_bucket(idx - qpos[None, :, None])]
        logits = logits + jnp.transpose(bias, (0, 3, 1, 2)).astype(jnp.float32)
        ok = valid[idx] & (chunk[idx] <= qchunk[None, :, None])
        logits = jnp.where(ok[:, None], logits, NEG_INF)
        p = jax.nn.softmax(logits, axis=-1).astype(v.dtype)
        return jnp.einsum('bhqk,bqkhd->bqhd', p, vg)

    out = lax.map(block, jnp.arange(P // Q_BLOCK))
    return jnp.transpose(out, (1, 0, 2, 3, 4)).reshape(bsz, P, H, dh)


def gla_chunked(q, k, v, log_a):
    dk = q.shape[-1]
    q, k, v, log_a = to_chunks(q) * dk ** -0.5, to_chunks(k), to_chunks(v), to_chunks(log_a)
    bcum = jnp.cumsum(log_a, axis=3)
    b_last = bcum[:, :, :, -1:, :]
    q_t = q * jnp.exp(bcum)
    k_t = k * jnp.exp(-bcum)
    causal = jnp.tril(jnp.ones((CHUNK, CHUNK), dtype=bool))
    att = jnp.where(causal, jnp.einsum('bhncd,bhnsd->bhncs', q_t, k_t), 0.0)
    o_intra = jnp.einsum('bhncs,bhnse->bhnce', att, v)
    contrib = jnp.einsum('bhncd,bhnce->bhnde', k * jnp.exp(b_last - bcum), v)
    decay = jnp.exp(b_last[:, :, :, 0, :])

    def step(S, inp):
        dec, con = inp
        return S * dec[..., None] + con, S

    S0 = jnp.zeros(contrib.shape[:2] + contrib.shape[3:], jnp.float32)
    _, S_before = lax.scan(step, S0, (jnp.moveaxis(decay, 2, 0), jnp.moveaxis(contrib, 2, 0)))
    S_before = jnp.moveaxis(S_before, 0, 2)
    o_inter = jnp.einsum('bhncd,bhnde->bhnce', q_t, S_before)
    return from_chunks(o_intra + o_inter)


def retention_chunked(q, k, v, log_gamma):
    dk = q.shape[-1]
    q, k, v = to_chunks(q), to_chunks(k) * dk ** -0.5, to_chunks(v)
    i = jnp.arange(CHUNK, dtype=jnp.float32)
    diff = i[:, None] - i[None, :]
    dmat = jnp.where(diff >= 0, jnp.exp(log_gamma[:, None, None] * jnp.maximum(diff, 0.0)), 0.0)
    att = jnp.einsum('bhncd,bhnsd->bhncs', q, k) * dmat[None, :, None]
    o_intra = jnp.einsum('bhncs,bhnse->bhnce', att, v)
    zeta = jnp.exp(log_gamma[:, None] * (CHUNK - 1 - i))
    xi = jnp.exp(log_gamma[:, None] * (i + 1))
    contrib = jnp.einsum('bhncd,bhnce->bhnde', k * zeta[None, :, None, :, None], v)
    chunk_decay = jnp.exp(log_gamma * CHUNK)[None, :, None, None]

    def step(S, con):
        return S * chunk_decay + con, S

    S0 = jnp.zeros(contrib.shape[:2] + contrib.shape[3:], jnp.float32)
    _, S_before = lax.scan(step, S0, jnp.moveaxis(contrib, 2, 0))
    S_before = jnp.moveaxis(S_before, 0, 2)
    o_inter = jnp.einsum('bhncd,bhnde->bhnce', q * xi[None, :, None, :, None], S_before)
    return from_chunks(o_intra + o_inter)


def stick_breaking(q, k, v, valid):
    bsz, P, H, dh = q.shape
    kpos = jnp.arange(P, dtype=jnp.int32)

    def block(i):
        s0 = i * Q_BLOCK
        qb = lax.dynamic_slice_in_dim(q, s0, Q_BLOCK, axis=1)
        qpos = s0 + jnp.arange(Q_BLOCK, dtype=jnp.int32)
        z = jnp.einsum('bqhd,bshd->bhqs', qb, k).astype(jnp.float32) * dh ** -0.5
        ok = ((kpos[None, :] < qpos[:, None]) & valid[None, :])[None, None]
        log_1m = jnp.where(ok, -jax.nn.softplus(z), 0.0)
        after = lax.cumsum(log_1m, axis=3, reverse=True) - log_1m
        w = jnp.where(ok, jnp.exp(jax.nn.log_sigmoid(z) + after), 0.0)
        return jnp.einsum('bhqs,bshd->bqhd', w.astype(v.dtype), v)

    out = lax.map(block, jnp.arange(P // Q_BLOCK))
    return jnp.transpose(out, (1, 0, 2, 3, 4)).reshape(bsz, P, H, dh)


def layer_ab(h, w_in, gate_w2, gate_b, w_out, rel_bias, chunk, valid, topk):
    bsz, P, _ = h.shape
    aq, ak, av, ag, iq, ik, iw, bq, bk, bv, bg, ba = split_cols(h @ w_in, SPLIT_AB)
    hd = lambda t, nh: t.reshape(bsz, P, nh, -1)
    oa = dsa_attention(hd(aq, A_HEADS), hd(ak, A_HEADS), hd(av, A_HEADS),
                       hd(iq, IDX_HEADS), ik, iw, rel_bias, chunk, valid, topk)
    oa = oa.reshape(bsz, P, -1) * jax.nn.silu(ag)
    log_a = jax.nn.log_sigmoid((ba @ gate_w2 + gate_b).astype(jnp.float32)) / GLA_TAU
    f = lambda t, nh: hd(t, nh).astype(jnp.float32)
    ob = gla_chunked(f(bq, B_HEADS), f(bk, B_HEADS), f(bv, B_HEADS), hd(log_a, B_HEADS))
    ob = head_rms(ob).reshape(bsz, P, -1).astype(h.dtype) * jax.nn.silu(bg)
    return jnp.concatenate([oa, ob], axis=-1) @ w_out


def layer_cd(h, w_in, w_out, log_gamma, pos, valid):
    bsz, P, _ = h.shape
    cq, ck, cv, cg, dq, dk, dv, dg = split_cols(h @ w_in, SPLIT_CD)
    hd = lambda t, nh: t.reshape(bsz, P, nh, -1)
    f = lambda t, nh: hd(t, nh).astype(jnp.float32)
    oc = retention_chunked(rotary(f(cq, C_HEADS), pos), rotary(f(ck, C_HEADS), pos),
                           f(cv, C_HEADS), log_gamma)
    oc = head_layer_norm(oc).reshape(bsz, P, -1).astype(h.dtype) * jax.nn.silu(cg)
    od = stick_breaking(hd(dq, D_HEADS), hd(dk, D_HEADS), hd(dv, D_HEADS), valid)
    od = od.reshape(bsz, P, -1) * jax.nn.silu(dg)
    return jnp.concatenate([oc, od], axis=-1) @ w_out


def setup_inputs(seed: int = 0) -> dict:
    key = jax.random.key(seed)
    ks = jax.random.split(key, 11)
    n_even = (DEPTH + 1) // 2
    n_odd = DEPTH // 2
    f32 = jnp.float32
    nrm = lambda k, shape, fan: jax.random.normal(k, shape, f32) * fan ** -0.5
    return {
        'x': jax.random.normal(ks[0], (BATCH, SEQ, D_MODEL), f32),
        'meta_tokens': jax.random.normal(ks[1], (N_META, D_MODEL), f32),
        'rel_bias': 0.1 * jax.random.normal(ks[2], (REL_BUCKETS, A_HEADS), f32),
        'norm_g': 1.0 + 0.02 * jax.random.normal(ks[3], (DEPTH, D_MODEL), f32),
        'final_g': 1.0 + 0.02 * jax.random.normal(ks[4], (D_MODEL,), f32),
        'w_in_ab': nrm(ks[5], (n_even, D_MODEL, W_AB), D_MODEL),
        'gla_gate_w2': nrm(ks[6], (n_even, GLA_GATE_RANK, B_HEADS * B_DK), GLA_GATE_RANK),
        'gla_gate_b': 0.1 * jax.random.normal(ks[7], (n_even, B_HEADS * B_DK), f32),
        'w_out_ab': nrm(ks[8], (n_even, MIX_AB, D_MODEL), MIX_AB),
        'w_in_cd': nrm(ks[9], (n_odd, D_MODEL, W_CD), D_MODEL),
        'w_out_cd': nrm(ks[10], (n_odd, MIX_CD, D_MODEL), MIX_CD),
    }


def reference(x, meta_tokens, rel_bias, norm_g, final_g, w_in_ab, gla_gate_w2, gla_gate_b,
              w_out_ab, w_in_cd, w_out_cd):
    bsz, seq, d = x.shape
    P = seq + PAD_FRONT + N_META
    h = jnp.concatenate([jnp.zeros((bsz, PAD_FRONT, d), x.dtype),
                         jnp.broadcast_to(meta_tokens.astype(x.dtype)[None], (bsz, N_META, d)),
                         x], axis=1)
    pos = jnp.arange(P, dtype=jnp.int32)
    chunk = pos // CHUNK
    valid = pos >= PAD_FRONT
    topk = min(TOPK_MAX, seq // 4)
    log_gamma = jnp.log(1.0 - jnp.exp2(-5.0 - jnp.arange(C_HEADS, dtype=jnp.float32)))
    for layer in range(DEPTH):
        hn = rms_norm(h, norm_g[layer])
        j = layer // 2
        if layer % 2 == 0:
            out = layer_ab(hn, w_in_ab[j], gla_gate_w2[j], gla_gate_b[j], w_out_ab[j],
                           rel_bias, chunk, valid, topk)
        else:
            out = layer_cd(hn, w_in_cd[j], w_out_cd[j], log_gamma, pos, valid)
        h = h + jnp.where(valid[None, :, None], out, 0.0).astype(h.dtype)
    return rms_norm(h[:, PAD_FRONT + N_META:], final_g)
```

```cpp
#include <hip/hip_runtime.h>
#include <hip/hip_cooperative_groups.h>
#include <stdint.h>
#include <cstdio>
namespace cg = cooperative_groups;

typedef unsigned short u16;
typedef __attribute__((ext_vector_type(8))) short bf16x8;
typedef __attribute__((ext_vector_type(4))) float f32x4;

#define DI __device__ __forceinline__
DI int lnd_v(int x) { asm volatile("" : "+v"(x)); return x; }
DI int lnd_s(int x) { asm volatile("" : "+s"(x)); return x; }
#define PHASE_IDS const int tid_ = lnd_v(wv_ * 64 + (int)__builtin_amdgcn_mbcnt_hi(~0u, __builtin_amdgcn_mbcnt_lo(~0u, (unsigned)lnd_s(0)))); const int bid_ = lnd_s((int)blockIdx.x); const int nblk_ = lnd_s((int)gridDim.x); (void)tid_; (void)bid_; (void)nblk_;

constexpr int SEQ = 8192, P = 8320, NB = 4, NROWS = NB * P;
constexpr int LD_AB = 3200, LD_CD = 3584;
constexpr int NTHR = 512;
constexpr float IDX_SCALE = 0.044194173824159216f;
constexpr int SMEM_BYTES = 77824;
#ifndef DBL
#define DBL 0
#endif
#define REP(bit) for (int rep_ = 0; rep_ < (((DBL) >> (bit)) & 1) + 1; ++rep_)

struct Params {
  const float *x, *meta, *rel_bias, *norm_g, *final_g, *w_in_ab, *gate_w2, *gate_b, *w_out_ab, *w_in_cd, *w_out_cd;
  float* out;
  u16 *wab_t, *wcd_t, *wout_t, *hn, *proj, *idx, *vt, *kc, *vc, *ikc;
  float *runc, *rund, *hmeta, *tcos, *tsin, *ss;
  u16* hg;
  unsigned* bar;
};

DI u16 f2bf(float x) { unsigned u = __float_as_uint(x); u += 0x7fffu + ((u >> 16) & 1u); return (u16)(u >> 16); }
DI float bf2f(u16 h) { return __uint_as_float(((unsigned)h) << 16); }
typedef __attribute__((ext_vector_type(2))) float f32x2_t;
typedef __attribute__((ext_vector_type(2))) __bf16 bf16x2_t;
DI unsigned pack2(float a, float b) { f32x2_t v = {a, b}; return __builtin_bit_cast(unsigned, __builtin_convertvector(v, bf16x2_t)); }
DI float dot2bf(unsigned a, unsigned b, float c) { return __builtin_amdgcn_fdot2_f32_bf16(__builtin_bit_cast(bf16x2_t, a), __builtin_bit_cast(bf16x2_t, b), c, false); }
DI float bflo(unsigned u) { return __uint_as_float(u << 16); }
DI float bfhi(unsigned u) { return __uint_as_float(u & 0xffff0000u); }
DI float silu(float x) { return x * __builtin_amdgcn_rcpf(1.f + __expf(-x)); }

DI float dpp_ror8(float v) { return __int_as_float(__builtin_amdgcn_update_dpp(0, __float_as_int(v), 0x128, 0xf, 0xf, false)); }
DI float dpp_xor1(float v) { return __int_as_float(__builtin_amdgcn_update_dpp(0, __float_as_int(v), 0xB1, 0xf, 0xf, false)); }
DI float dpp_xor2(float v) { return __int_as_float(__builtin_amdgcn_update_dpp(0, __float_as_int(v), 0x4E, 0xf, 0xf, false)); }
DI float dpp_hmir(float v) { return __int_as_float(__builtin_amdgcn_update_dpp(0, __float_as_int(v), 0x141, 0xf, 0xf, false)); }

DI float shx(float v, int lane, int m) { return __int_as_float(__builtin_amdgcn_ds_bpermute((lane ^ m) << 2, __float_as_int(v))); }
DI int bperm_i(int v, int srclane) { return __builtin_amdgcn_ds_bpermute(srclane << 2, v); }

DI float* hrow(const Params& p, int b, int pos) {
  return pos >= 128 ? p.out + ((size_t)(b * SEQ + pos - 128)) * 1024 : p.hmeta + (size_t)(b * 16 + pos - 112) * 1024;
}

DI void phase_prep(const int wv_, const Params& p) {
  PHASE_IDS
  const size_t gt = (size_t)bid_ * NTHR + tid_, gs = (size_t)nblk_ * NTHR;
  {
    const int wave = tid_ >> 6, lane = tid_ & 63;
    for (int R = bid_ * 8 + wave; R < NROWS; R += nblk_ * 8) {
      const int b = R / P, pos = R - b * P;
      u16* dst = p.hg + (size_t)R * 1024;
      float ssum = 0.f;
      if (pos < 112) {
        uint4 z = make_uint4(0, 0, 0, 0);
        ((uint4*)dst)[lane * 2] = z; ((uint4*)dst)[lane * 2 + 1] = z;
      } else {
        const float4* src = (const float4*)(pos >= 128 ? p.x + ((size_t)(b * SEQ + pos - 128)) * 1024 : p.meta + (size_t)(pos - 112) * 1024);
        float4* hdst = (float4*)hrow(p, b, pos);
#pragma unroll
        for (int i = 0; i < 4; ++i) {
          float4 v = src[lane + i * 64];
          hdst[lane + i * 64] = v;
          ssum += v.x * v.x + v.y * v.y + v.z * v.z + v.w * v.w;
          float4 gg = ((const float4*)p.norm_g)[lane + i * 64];
          uint2 o; o.x = pack2(v.x * gg.x, v.y * gg.y); o.y = pack2(v.z * gg.z, v.w * gg.w);
          ((uint2*)dst)[lane + i * 64] = o;
        }
#pragma unroll
        for (int o = 32; o >= 1; o >>= 1) ssum += shx(ssum, lane, o);
      }
      if (lane < 16) p.ss[(size_t)R * 16 + lane] = lane == 0 ? ssum : 0.f;
    }
  }
  for (size_t i = gt; i < (size_t)P * 32; i += gs) {
    int pos = (int)(i >> 5), d2 = (int)(i & 31);
    float inv = exp2f(-(float)d2 * (13.287712379549449f / 32.f));
    float ang = (float)pos * inv;
    p.tcos[i] = cosf(ang); p.tsin[i] = sinf(ang);
  }
  for (size_t i = gt; i < (size_t)2 * 128 * 4224; i += gs) {
    int n = (int)(i % 4224); int k8 = (int)((i / 4224) % 128); int j = (int)(i / (4224 * 128));
    float v[8];
#pragma unroll
    for (int q = 0; q < 8; ++q) v[q] = n < 4184 ? p.w_in_ab[((size_t)j * 1024 + k8 * 8 + q) * 4184 + n] : 0.f;
    uint4 o; o.x = pack2(v[0], v[1]); o.y = pack2(v[2], v[3]); o.z = pack2(v[4], v[5]); o.w = pack2(v[6], v[7]);
    *(uint4*)(p.wab_t + ((size_t)(j * 4224 + n)) * 1024 + k8 * 8) = o;
  }
  for (size_t i = gt; i < (size_t)2 * 128 * 3584; i += gs) {
    int n = (int)(i % 3584); int k8 = (int)((i / 3584) % 128); int j = (int)(i / (3584 * 128));
    float v[8];
#pragma unroll
    for (int q = 0; q < 8; ++q) v[q] = p.w_in_cd[((size_t)j * 1024 + k8 * 8 + q) * 3584 + n];
    uint4 o; o.x = pack2(v[0], v[1]); o.y = pack2(v[2], v[3]); o.z = pack2(v[4], v[5]); o.w = pack2(v[6], v[7]);
    *(uint4*)(p.wcd_t + ((size_t)(j * 3584 + n)) * 1024 + k8 * 8) = o;
  }
  for (size_t i = gt; i < (size_t)4 * 128 * 1024; i += gs) {
    int n = (int)(i % 1024); int k8 = (int)((i / 1024) % 128); int l = (int)(i / (1024 * 128));
    const float* src = ((l & 1) ? p.w_out_cd : p.w_out_ab) + (size_t)(l >> 1) * 1024 * 1024;
    float v[8];
#pragma unroll
    for (int q = 0; q < 8; ++q) v[q] = src[(size_t)(k8 * 8 + q) * 1024 + n];
    uint4 o; o.x = pack2(v[0], v[1]); o.y = pack2(v[2], v[3]); o.z = pack2(v[4], v[5]); o.w = pack2(v[6], v[7]);
    *(uint4*)(p.wout_t + ((size_t)(l * 1024 + n)) * 1024 + k8 * 8) = o;
  }
}

DI void phase_norm(const int wv_, const Params& p, const float* g) {
  PHASE_IDS
  const int wave = tid_ >> 6, lane = tid_ & 63;
  for (int R = bid_ * 8 + wave; R < NROWS; R += nblk_ * 8) {
    int b = R / P, pos = R - b * P;
    u16* dst = p.hn + (size_t)R * 1024;
    if (pos < 112) {
      uint4 z = make_uint4(0, 0, 0, 0);
      ((uint4*)dst)[lane * 2] = z; ((uint4*)dst)[lane * 2 + 1] = z;
      continue;
    }
    const float4* src = (const float4*)hrow(p, b, pos);
    float4 v[4]; float ss = 0.f;
#pragma unroll
    for (int i = 0; i < 4; ++i) { v[i] = src[lane + i * 64]; ss += v[i].x * v[i].x + v[i].y * v[i].y + v[i].z * v[i].z + v[i].w * v[i].w; }
#pragma unroll
    for (int o = 32; o >= 1; o >>= 1) ss += shx(ss, lane, o);
    float sc = rsqrtf(ss * (1.f / 1024.f) + 1e-6f);
#pragma unroll
    for (int i = 0; i < 4; ++i) {
      float4 gg = ((const float4*)g)[lane + i * 64];
      uint2 o; o.x = pack2(v[i].x * sc * gg.x, v[i].y * sc * gg.y); o.y = pack2(v[i].z * sc * gg.z, v[i].w * sc * gg.w);
      ((uint2*)dst)[lane + i * 64] = o;
    }
  }
}

DI float rowscale(const float* ss, int R) {
  const float4* q = (const float4*)(ss + (size_t)R * 16);
  float4 a = q[0], b = q[1], c = q[2], d = q[3];
  float t = ((a.x + a.y) + (a.z + a.w)) + ((b.x + b.y) + (b.z + b.w)) + ((c.x + c.y) + (c.z + c.w)) + ((d.x + d.y) + (d.z + d.w));
  return rsqrtf(t * (1.f / 1024.f) + 1e-6f);
}

template <int MODE, bool SWAP, int MT>
DI void gemm_tile(const int wv_, const Params& p, const u16* __restrict__ A, const u16* __restrict__ Bt, int brow, int bcol, char* smem, const float* gnext) {
  PHASE_IDS
  const int tid = tid_, wid = tid >> 6, lane = tid & 63, wr = wid >> 1, wc = wid & 1, fr = lane & 15, fq = lane >> 4;
  f32x4 acc[MT][4];
#pragma unroll
  for (int m = 0; m < MT; ++m)
#pragma unroll
    for (int n = 0; n < 4; ++n) acc[m][n] = f32x4{0.f, 0.f, 0.f, 0.f};
  const int ra = tid >> 2, cb = (tid & 3) * 8;
  const u16* ga0 = A + (size_t)(brow + ra) * 1024 + cb;
  const u16* ga1 = A + (size_t)(brow + 128 + ra) * 1024 + cb;
  const u16* gb0 = Bt + (size_t)(bcol + ra) * 1024 + cb;
  auto stage = [&](int t, int buf) {
    char* sA = smem + buf * 24576; char* sB = sA + 16384;
    if (MT >= 2 || tid < 256) __builtin_amdgcn_global_load_lds((const unsigned*)(ga0 + t * 32), (unsigned*)(sA + tid * 16), 16, 0, 0);
    if (MT == 4) __builtin_amdgcn_global_load_lds((const unsigned*)(ga1 + t * 32), (unsigned*)(sA + 8192 + tid * 16), 16, 0, 0);
    __builtin_amdgcn_global_load_lds((const unsigned*)(gb0 + t * 32), (unsigned*)(sB + tid * 16), 16, 0, 0);
  };
  stage(0, 0);
  for (int t = 0; t < 32; ++t) {
    asm volatile("s_waitcnt vmcnt(0)" ::: "memory");
    __syncthreads();
    if (t + 1 < 32) stage(t + 1, (t + 1) & 1);
    const char* sA = smem + (t & 1) * 24576; const char* sB = sA + 16384;
    bf16x8 Af[MT], Bf[4];
#pragma unroll
    for (int n = 0; n < 4; ++n) Bf[n] = *(const bf16x8*)(sB + (wc * 64 + n * 16 + fr) * 64 + fq * 16);
    constexpr int MH = MT >= 2 ? MT / 2 : 1;
#pragma unroll
    for (int m = 0; m < MH; ++m) Af[m] = *(const bf16x8*)(sA + (wr * (16 * MT) + m * 16 + fr) * 64 + fq * 16);
    __builtin_amdgcn_sched_barrier(0);
#pragma unroll
    for (int m = MH; m < MT; ++m) Af[m] = *(const bf16x8*)(sA + (wr * (16 * MT) + m * 16 + fr) * 64 + fq * 16);
#pragma unroll
    for (int m = 0; m < MH; ++m)
#pragma unroll
      for (int n = 0; n < 4; ++n)
        acc[m][n] = SWAP ? __builtin_amdgcn_mfma_f32_16x16x32_bf16(Bf[n], Af[m], acc[m][n], 0, 0, 0)
                         : __builtin_amdgcn_mfma_f32_16x16x32_bf16(Af[m], Bf[n], acc[m][n], 0, 0, 0);
    __builtin_amdgcn_sched_barrier(0);
#pragma unroll
    for (int m = MH; m < MT; ++m)
#pragma unroll
      for (int n = 0; n < 4; ++n)
        acc[m][n] = SWAP ? __builtin_amdgcn_mfma_f32_16x16x32_bf16(Bf[n], Af[m], acc[m][n], 0, 0, 0)
                         : __builtin_amdgcn_mfma_f32_16x16x32_bf16(Af[m], Bf[n], acc[m][n], 0, 0, 0);
  }
  __syncthreads();
  if (SWAP) {
#pragma unroll
    for (int m = 0; m < MT; ++m) {
      int R = brow + wr * (16 * MT) + m * 16 + fr;
      if (MODE == 2) {
        int b = R / P, pos = R - b * P;
        const bool valid = pos >= 112;
        float* hr = valid ? hrow(p, b, pos) : nullptr;
        float ssq = 0.f;
#pragma unroll
        for (int n = 0; n < 4; ++n) {
          int col = bcol + wc * 64 + n * 16 + fq * 4;
          float4 v = make_float4(0.f, 0.f, 0.f, 0.f);
          if (valid) {
            v = *(float4*)(hr + col);
            v.x += acc[m][n][0]; v.y += acc[m][n][1]; v.z += acc[m][n][2]; v.w += acc[m][n][3];
            *(float4*)(hr + col) = v;
          }
          if (gnext) {
            ssq += v.x * v.x + v.y * v.y + v.z * v.z + v.w * v.w;
            const float4 gg = *(const float4*)(gnext + col);
            uint2 o; o.x = pack2(v.x * gg.x, v.y * gg.y); o.y = pack2(v.z * gg.z, v.w * gg.w);
            *(uint2*)(p.hg + (size_t)R * 1024 + col) = o;
          }
        }
        if (gnext) {
          ssq += shx(ssq, lane, 16); ssq += shx(ssq, lane, 32);
          if (fq == 0) p.ss[(size_t)R * 16 + (bcol >> 7) * 2 + wc] = ssq;
        }
      } else {
        const float rs = rowscale(p.ss, R);
#pragma unroll
        for (int n = 0; n < 4; ++n) { acc[m][n][0] *= rs; acc[m][n][1] *= rs; acc[m][n][2] *= rs; acc[m][n][3] *= rs; }
        if (MODE == 0 && bcol >= 512 && bcol < 1536) {
          int b = R / P, pos = R - b * P;
          u16* dstb = (bcol < 1024 ? p.kc : p.vc);
#pragma unroll
          for (int n = 0; n < 4; ++n) {
            int cc = (bcol & 511) + wc * 64 + n * 16 + fq * 4;
            uint2 o; o.x = pack2(acc[m][n][0], acc[m][n][1]); o.y = pack2(acc[m][n][2], acc[m][n][3]);
            *(uint2*)(dstb + ((size_t)((b * 8 + (cc >> 6)) * P + pos)) * 64 + (cc & 63)) = o;
          }
        } else {
          const int LD = MODE == 0 ? LD_AB : LD_CD;
          u16* pr = p.proj + (size_t)R * LD;
#pragma unroll
          for (int n = 0; n < 4; ++n) {
            int col = bcol + wc * 64 + n * 16 + fq * 4;
            if (MODE == 1 || col < 4184) {
              uint2 o; o.x = pack2(acc[m][n][0], acc[m][n][1]); o.y = pack2(acc[m][n][2], acc[m][n][3]);
              int pcol = (MODE == 0 && col >= 1536) ? col - 1024 : col;
              *(uint2*)(pr + pcol) = o;
              if (MODE == 0 && col >= 2560 && col < 2624) *(uint2*)(p.ikc + (size_t)R * 64 + (col - 2560)) = o;
            }
          }
        }
      }
    }
  } else {
#pragma unroll
    for (int m = 0; m < MT; ++m) {
      int R = brow + wr * (16 * MT) + m * 16 + fq * 4;
      int b = R / P, pos = R - b * P;
      const float rs0 = rowscale(p.ss, R), rs1 = rowscale(p.ss, R + 1), rs2 = rowscale(p.ss, R + 2), rs3 = rowscale(p.ss, R + 3);
#pragma unroll
      for (int n = 0; n < 4; ++n) {
        int col = bcol + wc * 64 + n * 16 + fr - 2560;
        uint2 o; o.x = pack2(acc[m][n][0] * rs0, acc[m][n][1] * rs1); o.y = pack2(acc[m][n][2] * rs2, acc[m][n][3] * rs3);
        *(uint2*)(p.vt + ((size_t)(b * 512 + col)) * P + pos) = o;
      }
    }
  }
}

template <int MODE>
DI void phase_gemm(const int wv_, const Params& p, const u16* A, const u16* Bt, int NT, char* smem, const float* gnext) {
  PHASE_IDS
  const int ntiles = 130 * NT;
  const int nfull = (ntiles / nblk_) * nblk_;
  for (int tile = bid_; tile < nfull; tile += nblk_) {
    int tm = tile / NT, tn = tile - tm * NT;
    if (MODE == 1 && tn >= 20 && tn < 24) gemm_tile<1, false, 4>(wv_, p, A, Bt, tm * 256, tn * 128, smem, gnext);
    else gemm_tile<MODE, true, 4>(wv_, p, A, Bt, tm * 256, tn * 128, smem, gnext);
  }
  const int rem = ntiles - nfull;
  if (4 * rem <= nblk_) {
    for (int qt = bid_; qt < 4 * rem; qt += nblk_) {
      int tile = nfull + (qt >> 2);
      int tm = tile / NT, tn = tile - tm * NT;
      if (MODE == 1 && tn >= 20 && tn < 24) gemm_tile<1, false, 1>(wv_, p, A, Bt, tm * 256 + (qt & 3) * 64, tn * 128, smem, gnext);
      else gemm_tile<MODE, true, 1>(wv_, p, A, Bt, tm * 256 + (qt & 3) * 64, tn * 128, smem, gnext);
    }
  } else {
    for (int ht = bid_; ht < 2 * rem; ht += nblk_) {
      int tile = nfull + (ht >> 1);
      int tm = tile / NT, tn = tile - tm * NT;
      if (MODE == 1 && tn >= 20 && tn < 24) gemm_tile<1, false, 2>(wv_, p, A, Bt, tm * 256 + (ht & 1) * 128, tn * 128, smem, gnext);
      else gemm_tile<MODE, true, 2>(wv_, p, A, Bt, tm * 256 + (ht & 1) * 128, tn * 128, smem, gnext);
    }
  }
}

DI unsigned f2h_key(float x) {
  _Float16 h = (_Float16)x;
  unsigned u = (unsigned)__builtin_bit_cast(unsigned short, h);
  if (u == 0x8000u) u = 0u;
  return (u & 0x8000u) ? (u ^ 0xffffu) : (u | 0x8000u);
}
DI int dpp_scan_incl(int x) {
  x += __builtin_amdgcn_update_dpp(0, x, 0x111, 0xf, 0xf, true);
  x += __builtin_amdgcn_update_dpp(0, x, 0x112, 0xf, 0xf, true);
  x += __builtin_amdgcn_update_dpp(0, x, 0x114, 0xf, 0xf, true);
  x += __builtin_amdgcn_update_dpp(0, x, 0x118, 0xf, 0xf, true);
  x += __builtin_amdgcn_update_dpp(0, x, 0x142, 0xa, 0xf, false);
  x += __builtin_amdgcn_update_dpp(0, x, 0x143, 0xc, 0xf, false);
  return x;
}
constexpr int SEL_ROW = 8208;
constexpr int SEL_HIST = 4 * SEL_ROW * 2;
constexpr int SEL_HIST2 = SEL_HIST + 4 * 512 * 4;
constexpr int SEL_MISC = SEL_HIST2 + 4 * 64 * 4;

DI void phase_sel(const int wv_, const Params& p, char* smem, unsigned* ctr) {
  PHASE_IDS
  const int wave = tid_ >> 6, lane = tid_ & 63;
  u16* S = (u16*)smem;
  unsigned* hist = (unsigned*)(smem + SEL_HIST);
  unsigned* hist2 = (unsigned*)(smem + SEL_HIST2);
  int* misc = (int*)(smem + SEL_MISC);
  const int g = lane >> 4;
  const int qs = wave >> 1, t128 = (wave & 1) * 64 + lane;
  for (;;) {
    if (tid_ == 0) misc[24] = (int)atomicAdd(ctr, 1u);
    __syncthreads();
    const int item = misc[24];
    if (item >= 8000) break;
    const int b = item / 2000, qi = 1999 - (item - b * 2000), t0 = 320 + qi * 4;
    const int c = t0 >> 6, N = 64 * (c + 1) - 112, KT = N >> 4, ND = N >> 1;
    for (int i = tid_; i < 4 * 512 + 4 * 64; i += NTHR) hist[i] = 0u;
    {
      const int r16 = lane & 15, rq = r16 >> 2, rh = r16 & 3;
      const u16* rowq = p.proj + (size_t)(b * P + t0 + rq) * LD_AB + 1024 + g * 8;
      bf16x8 Af[2][2];
#pragma unroll
      for (int hq = 0; hq < 2; ++hq)
#pragma unroll
        for (int ks = 0; ks < 2; ++ks) Af[hq][ks] = *(const bf16x8*)(rowq + (hq * 4 + rh) * 64 + ks * 32);
      float w[8];
      {
        const uint4 wv4 = *(const uint4*)(p.proj + (size_t)(b * P + t0 + g) * LD_AB + 1600);
        w[0] = bflo(wv4.x) * IDX_SCALE; w[1] = bfhi(wv4.x) * IDX_SCALE; w[2] = bflo(wv4.y) * IDX_SCALE; w[3] = bfhi(wv4.y) * IDX_SCALE;
        w[4] = bflo(wv4.z) * IDX_SCALE; w[5] = bfhi(wv4.z) * IDX_SCALE; w[6] = bflo(wv4.w) * IDX_SCALE; w[7] = bfhi(wv4.w) * IDX_SCALE;
      }
      const u16* kbase = p.ikc + (size_t)(b * P + 112 + (lane & 15)) * 64 + g * 8;
      bf16x8 cur[2][2], nxt[2][2];
#pragma unroll
      for (int u = 0; u < 2; ++u) {
        int kk = wave + 8 * u; kk = kk < KT ? kk : KT - 1;
        const u16* pp = kbase + (size_t)kk * 16 * 64;
        cur[u][0] = *(const bf16x8*)pp; cur[u][1] = *(const bf16x8*)(pp + 32);
      }
      for (int kt0 = wave; kt0 < KT; kt0 += 16) {
#pragma unroll
        for (int u = 0; u < 2; ++u) {
          int kk = kt0 + 16 + 8 * u; kk = kk < KT ? kk : KT - 1;
          const u16* pp = kbase + (size_t)kk * 16 * 64;
          nxt[u][0] = *(const bf16x8*)pp; nxt[u][1] = *(const bf16x8*)(pp + 32);
        }
#pragma unroll
        for (int u = 0; u < 2; ++u) {
          const int kt = kt0 + 8 * u;
          float sc = 0.f;
#pragma unroll
          for (int hq = 0; hq < 2; ++hq) {
            f32x4 C = f32x4{0.f, 0.f, 0.f, 0.f};
            C = __builtin_amdgcn_mfma_f32_16x16x32_bf16(Af[hq][0], cur[u][0], C, 0, 0, 0);
            C = __builtin_amdgcn_mfma_f32_16x16x32_bf16(Af[hq][1], cur[u][1], C, 0, 0, 0);
#pragma unroll
            for (int j = 0; j < 4; ++j) sc = __builtin_fmaf(w[hq * 4 + j], __builtin_amdgcn_fmed3f(C[j], 0.f, __builtin_inff()), sc);
          }
          if (kt < KT) S[g * SEL_ROW + kt * 16 + (lane & 15)] = (u16)f2h_key(sc);
        }
#pragma unroll
        for (int u = 0; u < 2; ++u) { cur[u][0] = nxt[u][0]; cur[u][1] = nxt[u][1]; }
      }
    }
    __syncthreads();
    const unsigned* Srow = (const unsigned*)(S + qs * SEL_ROW);
    for (int i = t128; i < ND; i += 128) {
      unsigned kk = Srow[i];
      unsigned bA = (kk & 0xffffu) >> 6, bB = kk >> 22;
      atomicAdd(&hist[qs * 512 + (bA >> 1)], 1u << ((bA & 1) * 16));
      atomicAdd(&hist[qs * 512 + (bB >> 1)], 1u << ((bB & 1) * 16));
    }
    __syncthreads();
    int cb[8]; int csum = 0;
    {
#pragma unroll
      for (int i = 0; i < 4; ++i) {
        unsigned d = hist[qs * 512 + 511 - 4 * t128 - i];
        cb[2 * i] = (int)(d >> 16); cb[2 * i + 1] = (int)(d & 0xffffu);
        csum += cb[2 * i] + cb[2 * i + 1];
      }
    }
    int incl = dpp_scan_incl(csum);
    if (lane == 63) misc[wave] = incl;
    __syncthreads();
    if (wave & 1) incl += misc[wave - 1];
    {
      int above = incl - csum;
      if (above < 256 && 256 <= incl) {
        int cum = above, bsel = 0, Gsel = 0; bool done = false;
#pragma unroll
        for (int i = 0; i < 8; ++i) {
          if (!done) { if (cum + cb[i] >= 256) { bsel = 2 * (511 - 4 * t128 - (i >> 1)) + 1 - (i & 1); Gsel = cum; done = true; } else cum += cb[i]; }
        }
        misc[8 + 2 * qs] = bsel; misc[9 + 2 * qs] = Gsel;
      }
    }
    __syncthreads();
    const int b1 = misc[8 + 2 * qs], G1 = misc[9 + 2 * qs];
    for (int i = t128; i < ND; i += 128) {
      unsigned kk = Srow[i];
      unsigned kA = kk & 0xffffu, kB = kk >> 16;
      if ((int)(kA >> 6) == b1) atomicAdd(&hist2[qs * 64 + (kA & 63u)], 1u);
      if ((int)(kB >> 6) == b1) atomicAdd(&hist2[qs * 64 + (kB & 63u)], 1u);
    }
    __syncthreads();
    if ((wave & 1) == 0) {
      int cnt = (int)hist2[qs * 64 + 63 - lane];
      int inc2 = dpp_scan_incl(cnt);
      int ab2 = inc2 - cnt, need2 = 256 - G1;
      if (ab2 < need2 && need2 <= inc2) { misc[16 + 2 * qs] = (b1 << 6) | (63 - lane); misc[17 + 2 * qs] = G1 + ab2; }
    }
    __syncthreads();
    const unsigned T = (unsigned)misc[16 + 2 * qs]; const int G = misc[17 + 2 * qs], Rn = 256 - G;
    const int L = ((ND + 127) >> 7) | 1;
    const int i0 = t128 * L, i1 = (i0 + L < ND) ? i0 + L : ND;
    int cg_ = 0, ce_ = 0;
    for (int i = i0; i < i1; ++i) {
      unsigned kk = Srow[i];
      unsigned kA = kk & 0xffffu, kB = kk >> 16;
      cg_ += (kA > T) + (kB > T); ce_ += (kA == T) + (kB == T);
    }
    int pk = cg_ | (ce_ << 16);
    int pinc = dpp_scan_incl(pk);
    if (lane == 63) misc[wave] = pinc;
    __syncthreads();
    if (wave & 1) pinc += misc[wave - 1];
    {
      int pex = pinc - pk;
      int pg = pex & 0xffff, pe = pex >> 16;
      u16* outp = p.idx + (size_t)(b * P + t0 + qs) * 256;
      for (int i = i0; i < i1; ++i) {
        unsigned kk = Srow[i];
        unsigned kA = kk & 0xffffu, kB = kk >> 16;
        int sidx = 112 + 2 * i;
        if (kA > T) outp[pg++] = (u16)sidx; else if (kA == T) { if (pe < Rn) outp[G + pe] = (u16)sidx; ++pe; }
        if (kB > T) outp[pg++] = (u16)(sidx + 1); else if (kB == T) { if (pe < Rn) outp[G + pe] = (u16)(sidx + 1); ++pe; }
      }
    }
    __syncthreads();
  }
}

template <bool AV>
DI void att_item(const Params& p, const float* tb, const int head, const int lane, const int g, const int j, const int item) {
    const int b = item / 8208, t = 112 + (item - b * 8208);
    const int c = t >> 6, N = 64 * (c + 1) - 112;
    const int cnt = N < 256 ? N : 256;
    constexpr bool allvalid = AV;
    const u16* prow = p.proj + (size_t)(b * P + t) * LD_AB;
    const uint4 qv = *(const uint4*)(prow + head * 64 + j * 8);
    const uint4 gv = *(const uint4*)(prow + 512 + head * 64 + j * 8);
    const uint4* ip = (const uint4*)(p.idx + (size_t)(b * P + t) * 256 + g * 32);
    auto get_iv = [&](int ch) -> uint4 {
      uint4 v;
      if (N > 256) { v = ip[ch]; }
      else {
        unsigned wv[4];
#pragma unroll
        for (int w2 = 0; w2 < 4; ++w2) {
          int i0 = g * 32 + ch * 8 + 2 * w2, i1 = i0 + 1;
          unsigned s0 = 112 + (i0 < N ? i0 : 0), s1 = 112 + (i1 < N ? i1 : 0);
          wv[w2] = s0 | (s1 << 16);
        }
        v = make_uint4(wv[0], wv[1], wv[2], wv[3]);
      }
      return v;
    };
    const u16* kcol = p.kc + ((size_t)(b * 8 + head) * P) * 64 + j * 8;
    const u16* vcol = p.vc + ((size_t)(b * 8 + head) * P) * 64 + j * 8;
    float m = -1e30f, l = 0.f;
    float acc[8] = {0.f, 0.f, 0.f, 0.f, 0.f, 0.f, 0.f, 0.f};
    uint4 ivn = get_iv(0);
#pragma unroll 1
    for (int ch = 0; ch < 4; ++ch) {
      const uint4 iv4 = ivn;
      ivn = get_iv(ch < 3 ? ch + 1 : 3);
      const unsigned ivw[4] = {iv4.x, iv4.y, iv4.z, iv4.w};
      uint4 kv[8], va4[4], vb4[4];
      unsigned sidx[8];
#pragma unroll
      for (int e = 0; e < 8; ++e) {
        sidx[e] = (ivw[e >> 1] >> (16 * (e & 1))) & 0xffffu;
        kv[e] = *(const uint4*)(kcol + (size_t)sidx[e] * 64);
      }
#pragma unroll
      for (int e = 0; e < 4; ++e) va4[e] = *(const uint4*)(vcol + (size_t)sidx[e] * 64);
      float dd[8]; bool vld[8];
#pragma unroll
      for (int e = 0; e < 8; ++e) {
        int ni = t - (int)sidx[e]; ni = (ni > 127 ? 127 : ni) + 63;
        const float bias = tb[ni];
        float d = dot2bf(kv[e].x, qv.x, bias);
        d = dot2bf(kv[e].y, qv.y, d); d = dot2bf(kv[e].z, qv.z, d); d = dot2bf(kv[e].w, qv.w, d);
        d += dpp_xor1(d); d += dpp_xor2(d); d += dpp_hmir(d);
        vld[e] = allvalid || ((g * 32 + ch * 8 + e) < cnt);
        dd[e] = vld[e] ? d * 0.125f : -1e30f;
      }
#pragma unroll
      for (int e = 0; e < 4; ++e) vb4[e] = *(const uint4*)(vcol + (size_t)sidx[4 + e] * 64);
      float mn = fmaxf(fmaxf(fmaxf(dd[0], dd[1]), fmaxf(dd[2], dd[3])), fmaxf(fmaxf(dd[4], dd[5]), fmaxf(dd[6], dd[7])));
      mn = fmaxf(mn, m);
      const float scl = __expf(m - mn);
      m = mn;
      l *= scl;
#pragma unroll
      for (int i = 0; i < 8; ++i) acc[i] *= scl;
#pragma unroll
      for (int pr = 0; pr < 4; ++pr) {
        float p0 = vld[2 * pr] ? __expf(dd[2 * pr] - mn) : 0.f;
        float p1 = vld[2 * pr + 1] ? __expf(dd[2 * pr + 1] - mn) : 0.f;
        l += p0 + p1;
        const unsigned pp = pack2(p0, p1);
        const uint4 va = pr < 2 ? va4[2 * pr] : vb4[2 * pr - 4], vb = pr < 2 ? va4[2 * pr + 1] : vb4[2 * pr - 3];
        acc[0] = dot2bf(__builtin_amdgcn_perm(vb.x, va.x, 0x05040100u), pp, acc[0]);
        acc[1] = dot2bf(__builtin_amdgcn_perm(vb.x, va.x, 0x07060302u), pp, acc[1]);
        acc[2] = dot2bf(__builtin_amdgcn_perm(vb.y, va.y, 0x05040100u), pp, acc[2]);
        acc[3] = dot2bf(__builtin_amdgcn_perm(vb.y, va.y, 0x07060302u), pp, acc[3]);
        acc[4] = dot2bf(__builtin_amdgcn_perm(vb.z, va.z, 0x05040100u), pp, acc[4]);
        acc[5] = dot2bf(__builtin_amdgcn_perm(vb.z, va.z, 0x07060302u), pp, acc[5]);
        acc[6] = dot2bf(__builtin_amdgcn_perm(vb.w, va.w, 0x05040100u), pp, acc[6]);
        acc[7] = dot2bf(__builtin_amdgcn_perm(vb.w, va.w, 0x07060302u), pp, acc[7]);
      }
    }
    float M = fmaxf(m, dpp_ror8(m)); M = fmaxf(M, shx(M, lane, 16)); M = fmaxf(M, shx(M, lane, 32));
    float f = __expf(m - M);
    l *= f;
    l += dpp_ror8(l); l += shx(l, lane, 16); l += shx(l, lane, 32);
#pragma unroll
    for (int i = 0; i < 8; ++i) { acc[i] *= f; acc[i] += dpp_ror8(acc[i]); acc[i] += shx(acc[i], lane, 16); acc[i] += shx(acc[i], lane, 32); }
    if (g == 0) {
      float inv = 1.f / l;
      uint4 o;
      o.x = pack2(acc[0] * inv * silu(bflo(gv.x)), acc[1] * inv * silu(bfhi(gv.x)));
      o.y = pack2(acc[2] * inv * silu(bflo(gv.y)), acc[3] * inv * silu(bfhi(gv.y)));
      o.z = pack2(acc[4] * inv * silu(bflo(gv.z)), acc[5] * inv * silu(bfhi(gv.z)));
      o.w = pack2(acc[6] * inv * silu(bflo(gv.w)), acc[7] * inv * silu(bfhi(gv.w)));
      *(uint4*)(p.hn + (size_t)(b * P + t) * 1024 + head * 64 + j * 8) = o;
    }
}

DI void phase_att(const int wv_, const Params& p, char* smem, unsigned* ctr, const int head) {
  PHASE_IDS
  float* tb = (float*)smem;
  __syncthreads();
  if (tid_ < 191) {
    int n = tid_ - 63; int ret = n < 0 ? 16 : 0; n = n < 0 ? -n : n;
    int large = 2 + 31 - __clz(n * n | 1); large = large > 15 ? 15 : large;
    tb[tid_] = p.rel_bias[(ret + (n < 8 ? n : large)) * 8 + head];
  }
  __syncthreads();
  const int wave = tid_ >> 6, lane = tid_ & 63;
  const int g = lane >> 3, j = lane & 7;
  for (;;) {
    int ibase = 0;
    if (lane == 0) ibase = (int)atomicAdd(ctr + head, 12u);
    ibase = __builtin_amdgcn_readfirstlane(ibase);
    if (ibase >= 4 * 8208) break;
#pragma unroll 1
  for (int item = ibase; item < ibase + 12; ++item) {
    if (112 + (item % 8208) >= 320) att_item<true>(p, tb, head, lane, g, j, item); else att_item<false>(p, tb, head, lane, g, j, item);
  }
  }
}

DI float logsigmoidf(float x) { return fminf(x, 0.f) - __logf(1.f + __expf(-fabsf(x))); }

DI float rot_val(const u16* base, int d, int pos) {
  int d2 = d & 31;
  float x1 = bf2f(base[d2]), x2 = bf2f(base[32 + d2]);
  float inv = exp2f(-(float)d2 * (13.287712379549449f / 32.f));
  float ang = (float)pos * inv;
  float sn = sinf(ang), cs = cosf(ang);
  return d < 32 ? x1 * cs - x2 * sn : x1 * sn + x2 * cs;
}

template <int RET>
DI float compute_bcum(const int wv_, const Params& p, int lj, int b, int h, int n, float* bc, float* tot) {
  PHASE_IDS
  const int d = tid_ & 63, w = tid_ >> 6;
  float la[8];
  if (RET) {
    float lgam = logf(1.f - exp2f(-5.f - (float)h));
#pragma unroll
    for (int i = 0; i < 8; ++i) la[i] = lgam;
  } else {
    const float* W2 = p.gate_w2 + (size_t)lj * 16 * 256 + h * 64 + d;
    float wr[16];
#pragma unroll
    for (int r = 0; r < 16; ++r) wr[r] = W2[r * 256];
    float gb = p.gate_b[lj * 256 + h * 64 + d];
#pragma unroll
    for (int i = 0; i < 8; ++i) {
      const u16* ba = p.proj + (size_t)(b * P + n * 64 + 8 * w + i) * LD_AB + 3144;
      uint4 u0 = *(const uint4*)ba, u1 = *(const uint4*)(ba + 8);
      float x = gb;
      x += bflo(u0.x) * wr[0] + bfhi(u0.x) * wr[1] + bflo(u0.y) * wr[2] + bfhi(u0.y) * wr[3];
      x += bflo(u0.z) * wr[4] + bfhi(u0.z) * wr[5] + bflo(u0.w) * wr[6] + bfhi(u0.w) * wr[7];
      x += bflo(u1.x) * wr[8] + bfhi(u1.x) * wr[9] + bflo(u1.y) * wr[10] + bfhi(u1.y) * wr[11];
      x += bflo(u1.z) * wr[12] + bfhi(u1.z) * wr[13] + bflo(u1.w) * wr[14] + bfhi(u1.w) * wr[15];
      la[i] = logsigmoidf(x) * (1.f / 16.f);
    }
  }
  float run = 0.f;
#pragma unroll
  for (int i = 0; i < 8; ++i) { run += la[i]; la[i] = run; }
  tot[w * 64 + d] = run;
  __syncthreads();
  float off = 0.f, bl = 0.f;
#pragma unroll
  for (int w2 = 0; w2 < 8; ++w2) { float v = tot[w2 * 64 + d]; if (w2 < w) off += v; bl += v; }
#pragma unroll
  for (int i = 0; i < 8; ++i) bc[(8 * w + i) * 64 + d] = off + la[i];
  __syncthreads();
  return bl;
}

constexpr int GR = 5, NRUN = 26;
constexpr int G_QT = 16384, G_KT = G_QT + 9216, G_KP = G_KT + 9216, G_VT = G_KP + 9216, G_TOT = G_VT + 18432,
              G_RED = G_TOT + 2048, G_DEC = G_RED + 4096, G_BL = G_DEC + 256, G_ST = G_BL + 256;

DI bf16x8 pack8(const f32x4& a, const f32x4& b) {
  uint4 r; r.x = pack2(a[0], a[1]); r.y = pack2(a[2], a[3]); r.z = pack2(b[0], b[1]); r.w = pack2(b[2], b[3]);
  return __builtin_bit_cast(bf16x8, r);
}
DI bf16x8 ld_b64x2(const u16* lo, const u16* hi) {
  uint2 a = *(const uint2*)lo, b = *(const uint2*)hi;
  return __builtin_bit_cast(bf16x8, make_uint4(a.x, a.y, b.x, b.y));
}

template <int RET, bool FULL>
DI void phase_gla(const int wv_, const Params& p, int lj, char* smem) {
  PHASE_IDS
  float* bc = (float*)smem;
  u16* QT = (u16*)(smem + G_QT); u16* KT = (u16*)(smem + G_KT); u16* KP = (u16*)(smem + G_KP); u16* VT = (u16*)(smem + G_VT);
  float* tot = (float*)(smem + G_TOT); float* red = (float*)(smem + G_RED); float* decs = (float*)(smem + G_DEC);
  float* stt = (float*)(smem + G_ST);
  const int LD = RET ? LD_CD : LD_AB;
  const int lane = tid_ & 63, w = tid_ >> 6, r16 = lane & 15, g = lane >> 4;
  const int sc_ = tid_ >> 3, sdc = (tid_ & 7) * 8;
  const int scw = (((sc_ >> 3) ^ (tid_ & 7)) << 3) + (sc_ & 7);
  for (int item = bid_; item < 16 * NRUN; item += nblk_) {
    const int run = item % NRUN, bh = item / NRUN, h = bh & 3, b = bh >> 2;
    f32x4 Sreg[4];
#pragma unroll
    for (int dt = 0; dt < 4; ++dt) Sreg[dt] = f32x4{0.f, 0.f, 0.f, 0.f};
    float sumbl = 0.f;
    if (FULL) {
#pragma unroll 2
      for (int r2 = 0; r2 < run; ++r2) {
        const float4* cp = (const float4*)(p.runc + (((size_t)(bh * NRUN + r2) * 8 + w) * 64 + lane) * 16);
        const float4* dp = (const float4*)(p.rund + (size_t)(bh * NRUN + r2) * 64 + g * 16);
#pragma unroll
        for (int dt = 0; dt < 4; ++dt) {
          float4 cv = cp[dt], dv = dp[dt];
          Sreg[dt][0] = Sreg[dt][0] * dv.x + cv.x; Sreg[dt][1] = Sreg[dt][1] * dv.y + cv.y;
          Sreg[dt][2] = Sreg[dt][2] * dv.z + cv.z; Sreg[dt][3] = Sreg[dt][3] * dv.w + cv.w;
        }
      }
    }
    for (int ci = 0; ci < GR; ++ci) {
      const int n = run * GR + ci;
      float blast, lgam = 0.f;
      if (RET) {
        lgam = logf(1.f - exp2f(-5.f - (float)h));
        blast = 64.f * lgam;
        if (!FULL) __syncthreads();
      } else {
        blast = compute_bcum<RET>(wv_, p, lj, b, h, n, bc, tot);
        if (w == 0) decs[lane] = __expf(blast);
      }
      sumbl += blast;
#pragma unroll 1
      for (int hf = 0; hf < 2; ++hf) {
        const int pos = n * 64 + sc_;
        const int dd = sdc + 4 * hf;
        const u16* row = p.proj + (size_t)(b * P + pos) * LD;
        float kf[4], qf[4];
        if (RET) {
          const int d2 = dd & 31;
          const float4 cs = *(const float4*)(p.tcos + pos * 32 + d2), sn = *(const float4*)(p.tsin + pos * 32 + d2);
          const float csa[4] = {cs.x, cs.y, cs.z, cs.w}, sna[4] = {sn.x, sn.y, sn.z, sn.w};
          {
            const uint2 a = *(const uint2*)(row + 256 + h * 64 + d2), bb = *(const uint2*)(row + 256 + h * 64 + 32 + d2);
            const float x1[4] = {bflo(a.x), bfhi(a.x), bflo(a.y), bfhi(a.y)}, x2[4] = {bflo(bb.x), bfhi(bb.x), bflo(bb.y), bfhi(bb.y)};
#pragma unroll
            for (int i = 0; i < 4; ++i) kf[i] = dd < 32 ? x1[i] * csa[i] - x2[i] * sna[i] : x1[i] * sna[i] + x2[i] * csa[i];
          }
          if (FULL) {
            const uint2 a = *(const uint2*)(row + h * 64 + d2), bb = *(const uint2*)(row + h * 64 + 32 + d2);
            const float x1[4] = {bflo(a.x), bfhi(a.x), bflo(a.y), bfhi(a.y)}, x2[4] = {bflo(bb.x), bfhi(bb.x), bflo(bb.y), bfhi(bb.y)};
#pragma unroll
            for (int i = 0; i < 4; ++i) qf[i] = dd < 32 ? x1[i] * csa[i] - x2[i] * sna[i] : x1[i] * sna[i] + x2[i] * csa[i];
          }
        } else {
          const uint2 a = *(const uint2*)(row + 1864 + h * 64 + dd);
          kf[0] = bflo(a.x); kf[1] = bfhi(a.x); kf[2] = bflo(a.y); kf[3] = bfhi(a.y);
          if (FULL) {
            const uint2 q2 = *(const uint2*)(row + 1608 + h * 64 + dd);
            qf[0] = bflo(q2.x); qf[1] = bfhi(q2.x); qf[2] = bflo(q2.y); qf[3] = bfhi(q2.y);
          }
        }
        const u16* vr = row + (RET ? 512 : 2120) + h * 128 + dd;
        const uint2 v0 = *(const uint2*)vr, v1 = *(const uint2*)(vr + 64);
        float ev[4], bl[4];
        if (RET) {
          const float e0_ = (float)(sc_ + 1) * lgam;
          ev[0] = ev[1] = ev[2] = ev[3] = e0_; bl[0] = bl[1] = bl[2] = bl[3] = blast;
        } else {
          const float4 ev4 = *(const float4*)(bc + sc_ * 64 + dd), bl4 = *(const float4*)(bc + 63 * 64 + dd);
          ev[0] = ev4.x; ev[1] = ev4.y; ev[2] = ev4.z; ev[3] = ev4.w; bl[0] = bl4.x; bl[1] = bl4.y; bl[2] = bl4.z; bl[3] = bl4.w;
        }
        if (FULL) {
          uint2 o1, o2;
          o1.x = pack2(qf[0] * 0.125f * __expf(ev[0]), qf[1] * 0.125f * __expf(ev[1])); o1.y = pack2(qf[2] * 0.125f * __expf(ev[2]), qf[3] * 0.125f * __expf(ev[3]));
          o2.x = pack2(kf[0] * __expf(-ev[0]), kf[1] * __expf(-ev[1])); o2.y = pack2(kf[2] * __expf(-ev[2]), kf[3] * __expf(-ev[3]));
          *(uint2*)(QT + sc_ * 72 + dd) = o1; *(uint2*)(KT + sc_ * 72 + dd) = o2;
        }
#pragma unroll
        for (int i = 0; i < 4; ++i) {
          float kp = kf[i] * __expf(bl[i] - ev[i]);
          KP[(dd + i) * 72 + scw] = (u16)(pack2(kp, 0.f) & 0xffffu);
        }
        VT[(dd + 0) * 72 + scw] = (u16)(v0.x & 0xffffu); VT[(dd + 1) * 72 + scw] = (u16)(v0.x >> 16);
        VT[(dd + 2) * 72 + scw] = (u16)(v0.y & 0xffffu); VT[(dd + 3) * 72 + scw] = (u16)(v0.y >> 16);
        VT[(64 + dd + 0) * 72 + scw] = (u16)(v1.x & 0xffffu); VT[(64 + dd + 1) * 72 + scw] = (u16)(v1.x >> 16);
        VT[(64 + dd + 2) * 72 + scw] = (u16)(v1.y & 0xffffu); VT[(64 + dd + 3) * 72 + scw] = (u16)(v1.y >> 16);
      }
      __syncthreads();
      const int tl_ = lnd_v(tid_);
      const int r16 = tl_ & 15, g = (tl_ >> 4) & 3, w = tl_ >> 6;
      f32x4 o[4];
      if (FULL) {
#pragma unroll
        for (int ct = 0; ct < 4; ++ct) o[ct] = f32x4{0.f, 0.f, 0.f, 0.f};
#pragma unroll
        for (int kk = 0; kk < 2; ++kk) {
          const bf16x8 Bs = pack8(Sreg[2 * kk], Sreg[2 * kk + 1]);
#pragma unroll
          for (int ct = 0; ct < 4; ++ct) {
            const u16* qp = QT + (16 * ct + r16) * 72 + 32 * kk + 4 * g;
            o[ct] = __builtin_amdgcn_mfma_f32_16x16x32_bf16(ld_b64x2(qp, qp + 16), Bs, o[ct], 0, 0, 0);
          }
        }
#pragma unroll
        for (int ct = 0; ct < 4; ++ct) {
          const bf16x8 Bq0 = *(const bf16x8*)(QT + (16 * ct + r16) * 72 + 8 * g), Bq1 = *(const bf16x8*)(QT + (16 * ct + r16) * 72 + 32 + 8 * g);
          f32x4 at[4];
#pragma unroll
          for (int st = 0; st < 4; ++st) {
            at[st] = f32x4{0.f, 0.f, 0.f, 0.f};
            if (st <= ct) {
              const bf16x8 A0 = *(const bf16x8*)(KT + (16 * st + r16) * 72 + 8 * g), A1 = *(const bf16x8*)(KT + (16 * st + r16) * 72 + 32 + 8 * g);
              f32x4 acc = f32x4{0.f, 0.f, 0.f, 0.f};
              acc = __builtin_amdgcn_mfma_f32_16x16x32_bf16(A0, Bq0, acc, 0, 0, 0);
              acc = __builtin_amdgcn_mfma_f32_16x16x32_bf16(A1, Bq1, acc, 0, 0, 0);
              if (st == ct) {
#pragma unroll
                for (int j = 0; j < 4; ++j) acc[j] = (4 * g + j <= r16) ? acc[j] : 0.f;
              }
              at[st] = acc;
            }
          }
#pragma unroll
          for (int m = 0; m < 2; ++m) {
            if (2 * m <= ct) {
              const bf16x8 Aa = pack8(at[2 * m], at[2 * m + 1]);
              const int swv = (2 * w + (r16 >> 3)) & 7;
              const u16* vrow = VT + (16 * w + r16) * 72 + 4 * (g & 1);
              o[ct] = __builtin_amdgcn_mfma_f32_16x16x32_bf16(Aa, ld_b64x2(vrow + (((4 * m + (g >> 1)) ^ swv) << 3), vrow + (((4 * m + 2 + (g >> 1)) ^ swv) << 3)), o[ct], 0, 0, 0);
            }
          }
        }
      }
      {
        const int swb = (2 * w + (r16 >> 3)) & 7;
        const bf16x8 Bv0 = *(const bf16x8*)(VT + (16 * w + r16) * 72 + ((g ^ swb) << 3)), Bv1 = *(const bf16x8*)(VT + (16 * w + r16) * 72 + (((4 + g) ^ swb) << 3));
#pragma unroll
        for (int dt = 0; dt < 4; ++dt) {
          float4 dv;
          if (RET) { const float dc_ = __expf(blast); dv = make_float4(dc_, dc_, dc_, dc_); }
          else dv = *(const float4*)(decs + 16 * dt + 4 * g);
          f32x4 acc = f32x4{Sreg[dt][0] * dv.x, Sreg[dt][1] * dv.y, Sreg[dt][2] * dv.z, Sreg[dt][3] * dv.w};
          const int swa = (2 * dt + (r16 >> 3)) & 7;
          const bf16x8 A0 = *(const bf16x8*)(KP + (16 * dt + r16) * 72 + ((g ^ swa) << 3)), A1 = *(const bf16x8*)(KP + (16 * dt + r16) * 72 + (((4 + g) ^ swa) << 3));
          acc = __builtin_amdgcn_mfma_f32_16x16x32_bf16(A0, Bv0, acc, 0, 0, 0);
          acc = __builtin_amdgcn_mfma_f32_16x16x32_bf16(A1, Bv1, acc, 0, 0, 0);
          Sreg[dt] = acc;
        }
      }
      if (FULL) {
        const int gcol = (RET ? 1024 : 2632) + h * 128 + 16 * w + r16, ocol = (RET ? 0 : 512) + h * 128 + 16 * w + r16;
        u16 gq[16];
#pragma unroll
        for (int ct = 0; ct < 4; ++ct)
#pragma unroll
          for (int j = 0; j < 4; ++j) gq[ct * 4 + j] = p.proj[(unsigned)(b * P + n * 64 + 16 * ct + 4 * g + j) * (unsigned)LD + (unsigned)gcol];
#pragma unroll
        for (int ct = 0; ct < 4; ++ct)
#pragma unroll
          for (int j = 0; j < 4; ++j) {
            float s2 = o[ct][j] * o[ct][j], s1 = o[ct][j];
            s2 += dpp_xor1(s2); s2 += dpp_xor2(s2); s2 += dpp_hmir(s2); s2 += dpp_ror8(s2);
            if (RET) { s1 += dpp_xor1(s1); s1 += dpp_xor2(s1); s1 += dpp_hmir(s1); s1 += dpp_ror8(s1); }
            if (r16 == 0) { red[w * 64 + 16 * ct + 4 * g + j] = s2; if (RET) red[512 + w * 64 + 16 * ct + 4 * g + j] = s1; }
          }
        __syncthreads();
        if (tid_ < 64) {
          float t2 = 0.f, t1 = 0.f;
#pragma unroll
          for (int w2 = 0; w2 < 8; ++w2) { t2 += red[w2 * 64 + tid_]; if (RET) t1 += red[512 + w2 * 64 + tid_]; }
          float mean = RET ? t1 * (1.f / 128.f) : 0.f;
          float var = t2 * (1.f / 128.f) - mean * mean;
          stt[tid_] = rsqrtf(fmaxf(var, 0.f) + 1e-6f); stt[64 + tid_] = mean;
        }
        __syncthreads();
#pragma unroll
        for (int ct = 0; ct < 4; ++ct)
#pragma unroll
          for (int j = 0; j < 4; ++j) {
            const int c = 16 * ct + 4 * g + j;
            const unsigned R = (unsigned)(b * P + n * 64 + c);
            const float gate = bf2f(gq[ct * 4 + j]);
            const float val = (o[ct][j] - stt[64 + c]) * stt[c] * silu(gate);
            p.hn[R * 1024u + (unsigned)ocol] = (u16)(pack2(val, 0.f) & 0xffffu);
          }
      }
    }
    if (!FULL) {
      float* cp = p.runc + (((size_t)(bh * NRUN + run) * 8 + w) * 64 + lane) * 16;
#pragma unroll
      for (int dt = 0; dt < 4; ++dt) *(float4*)(cp + 4 * dt) = make_float4(Sreg[dt][0], Sreg[dt][1], Sreg[dt][2], Sreg[dt][3]);
      if (w == 0) { const int d = lane; p.rund[(size_t)(bh * NRUN + run) * 64 + ((d >> 2) & 3) * 16 + (d >> 4) * 4 + (d & 3)] = expf(sumbl); }
    }
    __syncthreads();
  }
}

DI void phase_sb(const int wv_, const Params& p) {
  PHASE_IDS
  const int wave = tid_ >> 6, lane = tid_ & 63;
  const int r = lane & 15, g = lane >> 4;
  const int gw = bid_ * 8 + wave, nw = nblk_ * 8;
  for (int item = gw; item < 4 * 8 * 513; item += nw) {
    const int rti = item % 513, h = (item / 513) & 7, b = item / (513 * 8);
    const int t0 = 112 + rti * 16, tq = t0 + r;
    const u16* qrow = p.proj + (size_t)(b * P + tq) * LD_CD + 1536 + h * 64 + g * 8;
    const bf16x8 qf0 = *(const bf16x8*)qrow, qf1 = *(const bf16x8*)(qrow + 32);
    f32x4 o[4];
#pragma unroll
    for (int i = 0; i < 4; ++i) o[i] = f32x4{0.f, 0.f, 0.f, 0.f};
    float A = 0.f;
    const u16* vtb = p.vt + (size_t)((b * 8 + h) * 64) * P;
    for (int kb = t0 & ~31; kb >= 96; kb -= 32) {
      f32x4 z[2];
#pragma unroll
      for (int blk = 0; blk < 2; ++blk) {
        const u16* kr = p.proj + (size_t)(b * P + kb + 16 * blk + r) * LD_CD + 2048 + h * 64 + g * 8;
        bf16x8 a0 = *(const bf16x8*)kr, a1 = *(const bf16x8*)(kr + 32);
        f32x4 zz = f32x4{0.f, 0.f, 0.f, 0.f};
        zz = __builtin_amdgcn_mfma_f32_16x16x32_bf16(a0, qf0, zz, 0, 0, 0);
        zz = __builtin_amdgcn_mfma_f32_16x16x32_bf16(a1, qf1, zz, 0, 0, 0);
        z[blk] = zz;
      }
      float L[2][4], lsg[2][4]; bool ok[2][4];
      float T0 = 0.f, T1 = 0.f;
#pragma unroll
      for (int blk = 0; blk < 2; ++blk)
#pragma unroll
        for (int j = 0; j < 4; ++j) {
          int s = kb + 16 * blk + 4 * g + j;
          float zv = z[blk][j] * 0.125f;
          bool okk = (s < tq) && (s >= 112);
          float tl = __logf(1.f + __expf(-fabsf(zv)));
          float sp = fmaxf(zv, 0.f) + tl;
          L[blk][j] = okk ? -sp : 0.f;
          lsg[blk][j] = fminf(zv, 0.f) - tl;
          ok[blk][j] = okk;
        }
#pragma unroll
      for (int j = 0; j < 4; ++j) { T0 += L[0][j]; T1 += L[1][j]; }
      float x1 = shx(T1, lane, 16), a1s = T1 + x1, po1 = shx(a1s, lane, 32), tot1 = a1s + po1;
      float hi1 = ((g & 1) == 0 ? x1 : 0.f) + ((g & 2) == 0 ? po1 : 0.f);
      float x0 = shx(T0, lane, 16), a0s = T0 + x0, po0 = shx(a0s, lane, 32), tot0 = a0s + po0;
      float hi0 = ((g & 1) == 0 ? x0 : 0.f) + ((g & 2) == 0 ? po0 : 0.f);
      float w1[4], w0[4];
      float run = A + hi1;
#pragma unroll
      for (int j = 3; j >= 0; --j) { w1[j] = ok[1][j] ? __expf(lsg[1][j] + run) : 0.f; run += L[1][j]; }
      run = A + tot1 + hi0;
#pragma unroll
      for (int j = 3; j >= 0; --j) { w0[j] = ok[0][j] ? __expf(lsg[0][j] + run) : 0.f; run += L[0][j]; }
      uint4 wp; wp.x = pack2(w0[0], w0[1]); wp.y = pack2(w0[2], w0[3]); wp.z = pack2(w1[0], w1[1]); wp.w = pack2(w1[2], w1[3]);
      bf16x8 wfrag = __builtin_bit_cast(bf16x8, wp);
#pragma unroll
      for (int eb = 0; eb < 4; ++eb) {
        const u16* vp = vtb + (size_t)(eb * 16 + r) * P + kb + 4 * g;
        uint2 lo = *(const uint2*)vp, hi = *(const uint2*)(vp + 16);
        uint4 vv = make_uint4(lo.x, lo.y, hi.x, hi.y);
        o[eb] = __builtin_amdgcn_mfma_f32_16x16x32_bf16(__builtin_bit_cast(bf16x8, vv), wfrag, o[eb], 0, 0, 0);
      }
      A += tot1 + tot0;
      if (__all(A < -104.f)) break;
    }
    const u16* grow = p.proj + (size_t)(b * P + tq) * LD_CD + 3072 + h * 64;
    u16* orow = p.hn + (size_t)(b * P + tq) * 1024 + 512 + h * 64;
#pragma unroll
    for (int eb = 0; eb < 4; ++eb) {
      int e = eb * 16 + 4 * g;
      uint2 gv = *(const uint2*)(grow + e);
      uint2 ov;
      ov.x = pack2(o[eb][0] * silu(bflo(gv.x)), o[eb][1] * silu(bfhi(gv.x)));
      ov.y = pack2(o[eb][2] * silu(bflo(gv.y)), o[eb][3] * silu(bfhi(gv.y)));
      *(uint2*)(orow + e) = ov;
    }
  }
}

DI void phase_final(const int wv_, const Params& p) {
  PHASE_IDS
  const int wave = tid_ >> 6, lane = tid_ & 63;
  for (int R = bid_ * 8 + wave; R < NB * SEQ; R += nblk_ * 8) {
    float4* row = (float4*)(p.out + (size_t)R * 1024);
    float4 v[4]; float ss = 0.f;
#pragma unroll
    for (int i = 0; i < 4; ++i) { v[i] = row[lane + i * 64]; ss += v[i].x * v[i].x + v[i].y * v[i].y + v[i].z * v[i].z + v[i].w * v[i].w; }
#pragma unroll
    for (int o = 32; o >= 1; o >>= 1) ss += shx(ss, lane, o);
    float sc = rsqrtf(ss * (1.f / 1024.f) + 1e-6f);
#pragma unroll
    for (int i = 0; i < 4; ++i) {
      float4 gg = ((const float4*)p.final_g)[lane + i * 64];
      row[lane + i * 64] = make_float4(v[i].x * sc * gg.x, v[i].y * sc * gg.y, v[i].z * sc * gg.z, v[i].w * sc * gg.w);
    }
  }
}

#define XB_TMO      128
#define XB_XCNT(j)  (256  + 64 * (j))
#define XB_XSUB(j)  (1280 + 64 * (j))
#define XB_XGEN(j)  (2304 + 64 * (j))
#define XB_TOP      3328
#define XB_TOPGEN   3392
#define XCD_BAR_WORDS 3456
#define XB_SPIN_CAP (1u << 22)
DI unsigned xb_ld(unsigned* p) { return __hip_atomic_load(p, __ATOMIC_RELAXED, __HIP_MEMORY_SCOPE_AGENT); }
DI unsigned xb_add(unsigned* p, unsigned v) { return __hip_atomic_fetch_add(p, v, __ATOMIC_RELAXED, __HIP_MEMORY_SCOPE_AGENT); }
DI unsigned xb_xcc_id() { return (unsigned)__builtin_amdgcn_s_getreg((3 << 11) | 20) & 0xFu; }
#define XB_SPIN(cond, bar) do { unsigned _sp = 0; while (cond) { __builtin_amdgcn_s_sleep(1); \
    if ((++_sp & 255u) == 0u) { if (xb_ld(&(bar)[XB_TMO])) break; if (_sp > XB_SPIN_CAP) { atomicAdd(&(bar)[XB_TMO], 1u); break; } } } } while (0)

DI void xcd_barrier_complete(unsigned* bar, unsigned x, unsigned G, unsigned& nloc, unsigned& nx, unsigned& popmask) {
  unsigned sum, cnt, mine, pm, sp = 0u;
  for (;;) {
    sum = 0u; cnt = 0u; mine = 0u; pm = 0u;
#pragma unroll
    for (unsigned j = 0; j < 16; ++j) { const unsigned c = xb_ld(&bar[XB_XCNT(j)]); sum += c; cnt += (c > 0u) ? 1u : 0u; pm |= (c > 0u) ? (1u << j) : 0u; mine = (j == x) ? c : mine; }
    if (sum == G) break;
    __builtin_amdgcn_s_sleep(1);
    if ((++sp & 255u) == 0u) { if (xb_ld(&bar[XB_TMO])) break; if (sp > XB_SPIN_CAP) { atomicAdd(&bar[XB_TMO], 1u); break; } }
  }
  nloc = mine > 0u ? mine : 1u; nx = cnt > 0u ? cnt : 1u; popmask = pm;
}

DI void grid_bar(const int wv_, unsigned* bar, const unsigned x, const unsigned nloc, const unsigned nx, unsigned& gen) {
  PHASE_IDS
  asm volatile("s_waitcnt vmcnt(0)" ::: "memory");
  __syncthreads();
  if (tid_ == 0) {
    __builtin_amdgcn_s_waitcnt(0);
    const unsigned old = xb_add(&bar[XB_XSUB(x)], 1u);
    if (old + 1u == (gen + 1u) * nloc) {
      __builtin_amdgcn_fence(__ATOMIC_RELEASE, "agent");
      asm volatile("s_waitcnt vmcnt(0)" ::: "memory");
      const unsigned og = xb_add(&bar[XB_TOP], 1u);
      if (og + 1u == (gen + 1u) * nx) xb_add(&bar[XB_TOPGEN], 1u);
      else { while (xb_ld(&bar[XB_TOPGEN]) == gen) __builtin_amdgcn_s_sleep(1); }
      __builtin_amdgcn_fence(__ATOMIC_ACQUIRE, "agent");
      xb_add(&bar[XB_XGEN(x)], 1u);
      asm volatile("s_waitcnt vmcnt(0)" ::: "memory");
    } else {
      while (xb_ld(&bar[XB_XGEN(x)]) == gen) __builtin_amdgcn_s_sleep(1);
      __builtin_amdgcn_fence(__ATOMIC_ACQUIRE, "agent");
      asm volatile("s_waitcnt vmcnt(0)" ::: "memory");
    }
  }
  __syncthreads();
  gen = (unsigned)__builtin_amdgcn_readfirstlane((int)(gen + 1u));
}

__global__ void __launch_bounds__(NTHR, 4) mega(Params p) {
  __shared__ __attribute__((aligned(16))) char smem[SMEM_BYTES];
  cg::grid_group grid = cg::this_grid();
  const int wv_ = __builtin_amdgcn_readfirstlane((int)threadIdx.x >> 6);
  unsigned gen = 0u;
  {
    const int t0_ = wv_ * 64 + (int)__builtin_amdgcn_mbcnt_hi(~0u, __builtin_amdgcn_mbcnt_lo(~0u, 0u));
    if (t0_ == 0) {
      volatile unsigned* st = (volatile unsigned*)(smem + SMEM_BYTES - 32);
      const unsigned x = xb_xcc_id();
      st[0] = 0u; st[1] = 0u; st[2] = x;
      (void)xb_add(&p.bar[XB_XCNT(x)], 1u);
    }
    __syncthreads();
  }
  REP(8) phase_prep(wv_, p);
  grid.sync();
  unsigned xcc_, nloc_, nx_; int ahead_;
  {
    volatile unsigned* st = (volatile unsigned*)(smem + SMEM_BYTES - 32);
    const int t0_ = wv_ * 64 + (int)__builtin_amdgcn_mbcnt_hi(~0u, __builtin_amdgcn_mbcnt_lo(~0u, 0u));
    if (t0_ == 0) {
      unsigned nloc = 0u, nx = 0u, pm = 0u;
      xcd_barrier_complete(p.bar, st[2], gridDim.x, nloc, nx, pm);
      st[0] = nloc; st[1] = nx; st[3] = pm;
    }
    __syncthreads();
    nloc_ = __builtin_amdgcn_readfirstlane(st[0]); nx_ = __builtin_amdgcn_readfirstlane(st[1]); xcc_ = __builtin_amdgcn_readfirstlane(st[2]);
    ahead_ = (__builtin_amdgcn_readfirstlane(st[3]) == 0xFFu) ? (int)(xcc_ & 7u) : (int)(blockIdx.x & 7u);
    __syncthreads();
  }
  for (int layer = 0; layer < 4; ++layer) {
    const int lj = layer >> 1;
    if ((layer & 1) == 0) {
      REP(0) phase_gemm<0>(wv_, p, p.hg, p.wab_t + (size_t)lj * 4224 * 1024, 33, smem, nullptr);
      REP(7) grid_bar(wv_, p.bar, xcc_, nloc_, nx_, gen);
      phase_gla<0, false>(wv_, p, lj, smem);
      REP(1) phase_sel(wv_, p, smem, p.bar + XCD_BAR_WORDS + lj);
      grid_bar(wv_, p.bar, xcc_, nloc_, nx_, gen);
      phase_gla<0, true>(wv_, p, lj, smem);
      REP(2) phase_att(wv_, p, smem, p.bar + XCD_BAR_WORDS + 32 + lj * 8, ahead_);
      grid_bar(wv_, p.bar, xcc_, nloc_, nx_, gen);
    } else {
      REP(0) phase_gemm<1>(wv_, p, p.hg, p.wcd_t + (size_t)lj * 3584 * 1024, 28, smem, nullptr);
      REP(7) grid_bar(wv_, p.bar, xcc_, nloc_, nx_, gen);
      phase_gla<1, false>(wv_, p, lj, smem);
      REP(5) phase_sb(wv_, p);
      grid_bar(wv_, p.bar, xcc_, nloc_, nx_, gen);
      phase_gla<1, true>(wv_, p, lj, smem);
      grid_bar(wv_, p.bar, xcc_, nloc_, nx_, gen);
    }
    phase_gemm<2>(wv_, p, p.hn, p.wout_t + (size_t)layer * 1024 * 1024, 8, smem, layer < 3 ? p.norm_g + (layer + 1) * 1024 : nullptr);
    REP(7) grid_bar(wv_, p.bar, xcc_, nloc_, nx_, gen);
  }
  phase_final(wv_, p);
}

extern "C" void kernel_launch(void* const* d_in, const int* in_sizes, int n_in, void* d_out, int out_size, void* d_ws, size_t ws_size,
                              hipStream_t stream) {
  static int grid_blocks = 0;
  if (!grid_blocks) {
    int dev = 0, cus = 0, per_cu = 0;
    hipGetDevice(&dev);
    hipDeviceGetAttribute(&cus, hipDeviceAttributeMultiprocessorCount, dev);
    hipOccupancyMaxActiveBlocksPerMultiprocessor(&per_cu, mega, NTHR, 0);
    if (per_cu > 2) per_cu = 2;
    grid_blocks = cus * per_cu;
  }
  Params p{};
  p.x = (const float*)d_in[0]; p.meta = (const float*)d_in[1]; p.rel_bias = (const float*)d_in[2];
  p.norm_g = (const float*)d_in[3]; p.final_g = (const float*)d_in[4]; p.w_in_ab = (const float*)d_in[5];
  p.gate_w2 = (const float*)d_in[6]; p.gate_b = (const float*)d_in[7]; p.w_out_ab = (const float*)d_in[8];
  p.w_in_cd = (const float*)d_in[9]; p.w_out_cd = (const float*)d_in[10];
  p.out = (float*)d_out;
  char* w = (char*)d_ws; size_t off = 0;
  auto take = [&](size_t bytes) { char* r = w + off; off += (bytes + 255) & ~(size_t)255; return r; };
  p.wab_t = (u16*)take((size_t)2 * 4224 * 1024 * 2);
  p.wcd_t = (u16*)take((size_t)2 * 3584 * 1024 * 2);
  p.wout_t = (u16*)take((size_t)4 * 1024 * 1024 * 2);
  p.hn = (u16*)take((size_t)NROWS * 1024 * 2);
  p.proj = (u16*)take((size_t)NROWS * LD_CD * 2);
  p.kc = (u16*)take((size_t)NB * 8 * P * 64 * 2);
  p.vc = (u16*)take((size_t)NB * 8 * P * 64 * 2);
  p.ikc = (u16*)take((size_t)NROWS * 64 * 2);
  p.runc = (float*)take((size_t)16 * NRUN * 8192 * 4);
  p.rund = (float*)take((size_t)16 * NRUN * 64 * 4);
  p.tcos = (float*)take((size_t)P * 32 * 4);
  p.tsin = (float*)take((size_t)P * 32 * 4);
  p.hmeta = (float*)take((size_t)NB * 16 * 1024 * 4);
  p.idx = (u16*)take((size_t)NROWS * 256 * 2);
  p.vt = p.kc;
  p.hg = (u16*)take((size_t)NROWS * 1024 * 2);
  p.ss = (float*)take((size_t)NROWS * 16 * 4);
  p.bar = (unsigned*)take(16384);
  hipMemsetAsync(p.bar, 0, 16384, stream);
  if (off > ws_size) { fprintf(stderr, "workspace too small: need %zu have %zu\n", off, ws_size); }
  void* args[] = {&p};
  hipError_t e = hipLaunchCooperativeKernel((void*)mega, dim3(grid_blocks), dim3(NTHR), args, 0, stream);
  if (e != hipSuccess) fprintf(stderr, "cooperative launch failed: %s (grid %d)\n", hipGetErrorString(e), grid_blocks);
}
```

```cpp
#include <hip/hip_runtime.h>
#include <hip/hip_cooperative_groups.h>
#include <stdint.h>
#include <cstdio>
namespace cg = cooperative_groups;

typedef unsigned short u16;
typedef __attribute__((ext_vector_type(8))) short bf16x8;
typedef __attribute__((ext_vector_type(4))) float f32x4;

#define DI __device__ __forceinline__
DI int lnd_v(int x) { asm volatile("" : "+v"(x)); return x; }
DI int lnd_s(int x) { asm volatile("" : "+s"(x)); return x; }
#define PHASE_IDS const int tid_ = lnd_v(wv_ * 64 + (int)__builtin_amdgcn_mbcnt_hi(~0u, __builtin_amdgcn_mbcnt_lo(~0u, (unsigned)lnd_s(0)))); const int bid_ = lnd_s((int)blockIdx.x); const int nblk_ = lnd_s((int)gridDim.x); (void)tid_; (void)bid_; (void)nblk_;

constexpr int SEQ = 8192, P = 8320, NB = 4, NROWS = NB * P;
constexpr int LD_AB = 3200, LD_CD = 3584;
constexpr int NTHR = 512;
constexpr float IDX_SCALE = 0.044194173824159216f;
constexpr int SMEM_BYTES = 77824;
#ifndef DBL
#define DBL 0
#endif
#define REP(bit) for (int rep_ = 0; rep_ < (((DBL) >> (bit)) & 1) + 1; ++rep_)

struct Params {
  const float *x, *meta, *rel_bias, *norm_g, *final_g, *w_in_ab, *gate_w2, *gate_b, *w_out_ab, *w_in_cd, *w_out_cd;
  float* out;
  u16 *wab_t, *wcd_t, *wout_t, *hn, *proj, *idx, *vt, *kc, *vc, *ikc;
  float *runc, *rund, *hmeta, *tcos, *tsin, *ss;
  u16* hg;
  unsigned* bar;
};

DI u16 f2bf(float x) { unsigned u = __float_as_uint(x); u += 0x7fffu + ((u >> 16) & 1u); return (u16)(u >> 16); }
DI float bf2f(u16 h) { return __uint_as_float(((unsigned)h) << 16); }
typedef __attribute__((ext_vector_type(2))) float f32x2_t;
typedef __attribute__((ext_vector_type(2))) __bf16 bf16x2_t;
DI unsigned pack2(float a, float b) { f32x2_t v = {a, b}; return __builtin_bit_cast(unsigned, __builtin_convertvector(v, bf16x2_t)); }
DI float dot2bf(unsigned a, unsigned b, float c) { return __builtin_amdgcn_fdot2_f32_bf16(__builtin_bit_cast(bf16x2_t, a), __builtin_bit_cast(bf16x2_t, b), c, false); }
DI float bflo(unsigned u) { return __uint_as_float(u << 16); }
DI float bfhi(unsigned u) { return __uint_as_float(u & 0xffff0000u); }
DI float silu(float x) { return x * __builtin_amdgcn_rcpf(1.f + __expf(-x)); }

DI float dpp_ror8(float v) { return __int_as_float(__builtin_amdgcn_update_dpp(0, __float_as_int(v), 0x128, 0xf, 0xf, false)); }
DI float dpp_xor1(float v) { return __int_as_float(__builtin_amdgcn_update_dpp(0, __float_as_int(v), 0xB1, 0xf, 0xf, false)); }
DI float dpp_xor2(float v) { return __int_as_float(__builtin_amdgcn_update_dpp(0, __float_as_int(v), 0x4E, 0xf, 0xf, false)); }
DI float dpp_hmir(float v) { return __int_as_float(__builtin_amdgcn_update_dpp(0, __float_as_int(v), 0x141, 0xf, 0xf, false)); }

DI float shx(float v, int lane, int m) { return __int_as_float(__builtin_amdgcn_ds_bpermute((lane ^ m) << 2, __float_as_int(v))); }
DI int bperm_i(int v, int srclane) { return __builtin_amdgcn_ds_bpermute(srclane << 2, v); }

DI float* hrow(const Params& p, int b, int pos) {
  return pos >= 128 ? p.out + ((size_t)(b * SEQ + pos - 128)) * 1024 : p.hmeta + (size_t)(b * 16 + pos - 112) * 1024;
}

DI void phase_prep(const int wv_, const Params& p) {
  PHASE_IDS
  const size_t gt = (size_t)bid_ * NTHR + tid_, gs = (size_t)nblk_ * NTHR;
  {
    const int wave = tid_ >> 6, lane = tid_ & 63;
    for (int R = bid_ * 8 + wave; R < NROWS; R += nblk_ * 8) {
      const int b = R / P, pos = R - b * P;
      u16* dst = p.hg + (size_t)R * 1024;
      float ssum = 0.f;
      if (pos < 112) {
        uint4 z = make_uint4(0, 0, 0, 0);
        ((uint4*)dst)[lane * 2] = z; ((uint4*)dst)[lane * 2 + 1] = z;
      } else {
        const float4* src = (const float4*)(pos >= 128 ? p.x + ((size_t)(b * SEQ + pos - 128)) * 1024 : p.meta + (size_t)(pos - 112) * 1024);
        float4* hdst = (float4*)hrow(p, b, pos);
#pragma unroll
        for (int i = 0; i < 4; ++i) {
          float4 v = src[lane + i * 64];
          hdst[lane + i * 64] = v;
          ssum += v.x * v.x + v.y * v.y + v.z * v.z + v.w * v.w;
          float4 gg = ((const float4*)p.norm_g)[lane + i * 64];
          uint2 o; o.x = pack2(v.x * gg.x, v.y * gg.y); o.y = pack2(v.z * gg.z, v.w * gg.w);
          ((uint2*)dst)[lane + i * 64] = o;
        }
#pragma unroll
        for (int o = 32; o >= 1; o >>= 1) ssum += shx(ssum, lane, o);
      }
      if (lane < 16) p.ss[(size_t)R * 16 + lane] = lane == 0 ? ssum : 0.f;
    }
  }
  for (size_t i = gt; i < (size_t)P * 32; i += gs) {
    int pos = (int)(i >> 5), d2 = (int)(i & 31);
    float inv = exp2f(-(float)d2 * (13.287712379549449f / 32.f));
    float ang = (float)pos * inv;
    p.tcos[i] = cosf(ang); p.tsin[i] = sinf(ang);
  }
  for (size_t i = gt; i < (size_t)2 * 128 * 4224; i += gs) {
    int n = (int)(i % 4224); int k8 = (int)((i / 4224) % 128); int j = (int)(i / (4224 * 128));
    float v[8];
#pragma unroll
    for (int q = 0; q < 8; ++q) v[q] = n < 4184 ? p.w_in_ab[((size_t)j * 1024 + k8 * 8 + q) * 4184 + n] : 0.f;
    uint4 o; o.x = pack2(v[0], v[1]); o.y = pack2(v[2], v[3]); o.z = pack2(v[4], v[5]); o.w = pack2(v[6], v[7]);
    *(uint4*)(p.wab_t + ((size_t)(j * 4224 + n)) * 1024 + k8 * 8) = o;
  }
  for (size_t i = gt; i < (size_t)2 * 128 * 3584; i += gs) {
    int n = (int)(i % 3584); int k8 = (int)((i / 3584) % 128); int j = (int)(i / (3584 * 128));
    float v[8];
#pragma unroll
    for (int q = 0; q < 8; ++q) v[q] = p.w_in_cd[((size_t)j * 1024 + k8 * 8 + q) * 3584 + n];
    uint4 o; o.x = pack2(v[0], v[1]); o.y = pack2(v[2], v[3]); o.z = pack2(v[4], v[5]); o.w = pack2(v[6], v[7]);
    *(uint4*)(p.wcd_t + ((size_t)(j * 3584 + n)) * 1024 + k8 * 8) = o;
  }
  for (size_t i = gt; i < (size_t)4 * 128 * 1024; i += gs) {
    int n = (int)(i % 1024); int k8 = (int)((i / 1024) % 128); int l = (int)(i / (1024 * 128));
    const float* src = ((l & 1) ? p.w_out_cd : p.w_out_ab) + (size_t)(l >> 1) * 1024 * 1024;
    float v[8];
#pragma unroll
    for (int q = 0; q < 8; ++q) v[q] = src[(size_t)(k8 * 8 + q) * 1024 + n];
    uint4 o; o.x = pack2(v[0], v[1]); o.y = pack2(v[2], v[3]); o.z = pack2(v[4], v[5]); o.w = pack2(v[6], v[7]);
    *(uint4*)(p.wout_t + ((size_t)(l * 1024 + n)) * 1024 + k8 * 8) = o;
  }
}

DI void phase_norm(const int wv_, const Params& p, const float* g) {
  PHASE_IDS
  const int wave = tid_ >> 6, lane = tid_ & 63;
  for (int R = bid_ * 8 + wave; R < NROWS; R += nblk_ * 8) {
    int b = R / P, pos = R - b * P;
    u16* dst = p.hn + (size_t)R * 1024;
    if (pos < 112) {
      uint4 z = make_uint4(0, 0, 0, 0);
      ((uint4*)dst)[lane * 2] = z; ((uint4*)dst)[lane * 2 + 1] = z;
      continue;
    }
    const float4* src = (const float4*)hrow(p, b, pos);
    float4 v[4]; float ss = 0.f;
#pragma unroll
    for (int i = 0; i < 4; ++i) { v[i] = src[lane + i * 64]; ss += v[i].x * v[i].x + v[i].y * v[i].y + v[i].z * v[i].z + v[i].w * v[i].w; }
#pragma unroll
    for (int o = 32; o >= 1; o >>= 1) ss += shx(ss, lane, o);
    float sc = rsqrtf(ss * (1.f / 1024.f) + 1e-6f);
#pragma unroll
    for (int i = 0; i < 4; ++i) {
      float4 gg = ((const float4*)g)[lane + i * 64];
      uint2 o; o.x = pack2(v[i].x * sc * gg.x, v[i].y * sc * gg.y); o.y = pack2(v[i].z * sc * gg.z, v[i].w * sc * gg.w);
      ((uint2*)dst)[lane + i * 64] = o;
    }
  }
}

DI float rowscale(const float* ss, int R) {
  const float4* q = (const float4*)(ss + (size_t)R * 16);
  float4 a = q[0], b = q[1], c = q[2], d = q[3];
  float t = ((a.x + a.y) + (a.z + a.w)) + ((b.x + b.y) + (b.z + b.w)) + ((c.x + c.y) + (c.z + c.w)) + ((d.x + d.y) + (d.z + d.w));
  return rsqrtf(t * (1.f / 1024.f) + 1e-6f);
}

template <int MODE, bool SWAP, int MT>
DI void gemm_tile(const int wv_, const Params& p, const u16* __restrict__ A, const u16* __restrict__ Bt, int brow, int bcol, char* smem, const float* gnext) {
  PHASE_IDS
  const int tid = tid_, wid = tid >> 6, lane = tid & 63, wr = wid >> 1, wc = wid & 1, fr = lane & 15, fq = lane >> 4;
  f32x4 acc[MT][4];
#pragma unroll
  for (int m = 0; m < MT; ++m)
#pragma unroll
    for (int n = 0; n < 4; ++n) acc[m][n] = f32x4{0.f, 0.f, 0.f, 0.f};
  const int ra = tid >> 2, cb = (tid & 3) * 8;
  const u16* ga0 = A + (size_t)(brow + ra) * 1024 + cb;
  const u16* ga1 = A + (size_t)(brow + 128 + ra) * 1024 + cb;
  const u16* gb0 = Bt + (size_t)(bcol + ra) * 1024 + cb;
  auto stage = [&](int t, int buf) {
    char* sA = smem + buf * 24576; char* sB = sA + 16384;
    if (MT >= 2 || tid < 256) __builtin_amdgcn_global_load_lds((const unsigned*)(ga0 + t * 32), (unsigned*)(sA + tid * 16), 16, 0, 0);
    if (MT == 4) __builtin_amdgcn_global_load_lds((const unsigned*)(ga1 + t * 32), (unsigned*)(sA + 8192 + tid * 16), 16, 0, 0);
    __builtin_amdgcn_global_load_lds((const unsigned*)(gb0 + t * 32), (unsigned*)(sB + tid * 16), 16, 0, 0);
  };
  stage(0, 0);
  for (int t = 0; t < 32; ++t) {
    asm volatile("s_waitcnt vmcnt(0)" ::: "memory");
    __syncthreads();
    if (t + 1 < 32) stage(t + 1, (t + 1) & 1);
    const char* sA = smem + (t & 1) * 24576; const char* sB = sA + 16384;
    bf16x8 Af[MT], Bf[4];
#pragma unroll
    for (int n = 0; n < 4; ++n) Bf[n] = *(const bf16x8*)(sB + (wc * 64 + n * 16 + fr) * 64 + fq * 16);
    constexpr int MH = MT >= 2 ? MT / 2 : 1;
#pragma unroll
    for (int m = 0; m < MH; ++m) Af[m] = *(const bf16x8*)(sA + (wr * (16 * MT) + m * 16 + fr) * 64 + fq * 16);
    __builtin_amdgcn_sched_barrier(0);
#pragma unroll
    for (int m = MH; m < MT; ++m) Af[m] = *(const bf16x8*)(sA + (wr * (16 * MT) + m * 16 + fr) * 64 + fq * 16);
#pragma unroll
    for (int m = 0; m < MH; ++m)
#pragma unroll
      for (int n = 0; n < 4; ++n)
        acc[m][n] = SWAP ? __builtin_amdgcn_mfma_f32_16x16x32_bf16(Bf[n], Af[m], acc[m][n], 0, 0, 0)
                         : __builtin_amdgcn_mfma_f32_16x16x32_bf16(Af[m], Bf[n], acc[m][n], 0, 0, 0);
    __builtin_amdgcn_sched_barrier(0);
#pragma unroll
    for (int m = MH; m < MT; ++m)
#pragma unroll
      for (int n = 0; n < 4; ++n)
        acc[m][n] = SWAP ? __builtin_amdgcn_mfma_f32_16x16x32_bf16(Bf[n], Af[m], acc[m][n], 0, 0, 0)
                         : __builtin_amdgcn_mfma_f32_16x16x32_bf16(Af[m], Bf[n], acc[m][n], 0, 0, 0);
  }
  __syncthreads();
  if (SWAP) {
#pragma unroll
    for (int m = 0; m < MT; ++m) {
      int R = brow + wr * (16 * MT) + m * 16 + fr;
      if (MODE == 2) {
        int b = R / P, pos = R - b * P;
        const bool valid = pos >= 112;
        float* hr = valid ? hrow(p, b, pos) : nullptr;
        float ssq = 0.f;
#pragma unroll
        for (int n = 0; n < 4; ++n) {
          int col = bcol + wc * 64 + n * 16 + fq * 4;
          float4 v = make_float4(0.f, 0.f, 0.f, 0.f);
          if (valid) {
            v = *(float4*)(hr + col);
            v.x += acc[m][n][0]; v.y += acc[m][n][1]; v.z += acc[m][n][2]; v.w += acc[m][n][3];
            *(float4*)(hr + col) = v;
          }
          if (gnext) {
            ssq += v.x * v.x + v.y * v.y + v.z * v.z + v.w * v.w;
            const float4 gg = *(const float4*)(gnext + col);
            uint2 o; o.x = pack2(v.x * gg.x, v.y * gg.y); o.y = pack2(v.z * gg.z, v.w * gg.w);
            *(uint2*)(p.hg + (size_t)R * 1024 + col) = o;
          }
        }
        if (gnext) {
          ssq += shx(ssq, lane, 16); ssq += shx(ssq, lane, 32);
          if (fq == 0) p.ss[(size_t)R * 16 + (bcol >> 7) * 2 + wc] = ssq;
        }
      } else {
        const float rs = rowscale(p.ss, R);
#pragma unroll
        for (int n = 0; n < 4; ++n) { acc[m][n][0] *= rs; acc[m][n][1] *= rs; acc[m][n][2] *= rs; acc[m][n][3] *= rs; }
        if (MODE == 0 && bcol >= 512 && bcol < 1536) {
          int b = R / P, pos = R - b * P;
          u16* dstb = (bcol < 1024 ? p.kc : p.vc);
#pragma unroll
          for (int n = 0; n < 4; ++n) {
            int cc = (bcol & 511) + wc * 64 + n * 16 + fq * 4;
            uint2 o; o.x = pack2(acc[m][n][0], acc[m][n][1]); o.y = pack2(acc[m][n][2], acc[m][n][3]);
            *(uint2*)(dstb + ((size_t)((b * 8 + (cc >> 6)) * P + pos)) * 64 + (cc & 63)) = o;
          }
        } else {
          const int LD = MODE == 0 ? LD_AB : LD_CD;
          u16* pr = p.proj + (size_t)R * LD;
#pragma unroll
          for (int n = 0; n < 4; ++n) {
            int col = bcol + wc * 64 + n * 16 + fq * 4;
            if (MODE == 1 || col < 4184) {
              uint2 o; o.x = pack2(acc[m][n][0], acc[m][n][1]); o.y = pack2(acc[m][n][2], acc[m][n][3]);
              int pcol = (MODE == 0 && col >= 1536) ? col - 1024 : col;
              *(uint2*)(pr + pcol) = o;
              if (MODE == 0 && col >= 2560 && col < 2624) *(uint2*)(p.ikc + (size_t)R * 64 + (col - 2560)) = o;
            }
          }
        }
      }
    }
  } else {
#pragma unroll
    for (int m = 0; m < MT; ++m) {
      int R = brow + wr * (16 * MT) + m * 16 + fq * 4;
      int b = R / P, pos = R - b * P;
      const float rs0 = rowscale(p.ss, R), rs1 = rowscale(p.ss, R + 1), rs2 = rowscale(p.ss, R + 2), rs3 = rowscale(p.ss, R + 3);
#pragma unroll
      for (int n = 0; n < 4; ++n) {
        int col = bcol + wc * 64 + n * 16 + fr - 2560;
        uint2 o; o.x = pack2(acc[m][n][0] * rs0, acc[m][n][1] * rs1); o.y = pack2(acc[m][n][2] * rs2, acc[m][n][3] * rs3);
        *(uint2*)(p.vt + ((size_t)(b * 512 + col)) * P + pos) = o;
      }
    }
  }
}

template <int MODE>
DI void phase_gemm(const int wv_, const Params& p, const u16* A, const u16* Bt, int NT, char* smem, const float* gnext) {
  PHASE_IDS
  const int ntiles = 130 * NT;
  const int nfull = (ntiles / nblk_) * nblk_;
  for (int tile = bid_; tile < nfull; tile += nblk_) {
    int tm = tile / NT, tn = tile - tm * NT;
    if (MODE == 1 && tn >= 20 && tn < 24) gemm_tile<1, false, 4>(wv_, p, A, Bt, tm * 256, tn * 128, smem, gnext);
    else gemm_tile<MODE, true, 4>(wv_, p, A, Bt, tm * 256, tn * 128, smem, gnext);
  }
  const int rem = ntiles - nfull;
  if (4 * rem <= nblk_) {
    for (int qt = bid_; qt < 4 * rem; qt += nblk_) {
      int tile = nfull + (qt >> 2);
      int tm = tile / NT, tn = tile - tm * NT;
      if (MODE == 1 && tn >= 20 && tn < 24) gemm_tile<1, false, 1>(wv_, p, A, Bt, tm * 256 + (qt & 3) * 64, tn * 128, smem, gnext);
      else gemm_tile<MODE, true, 1>(wv_, p, A, Bt, tm * 256 + (qt & 3) * 64, tn * 128, smem, gnext);
    }
  } else {
    for (int ht = bid_; ht < 2 * rem; ht += nblk_) {
      int tile = nfull + (ht >> 1);
      int tm = tile / NT, tn = tile - tm * NT;
      if (MODE == 1 && tn >= 20 && tn < 24) gemm_tile<1, false, 2>(wv_, p, A, Bt, tm * 256 + (ht & 1) * 128, tn * 128, smem, gnext);
      else gemm_tile<MODE, true, 2>(wv_, p, A, Bt, tm * 256 + (ht & 1) * 128, tn * 128, smem, gnext);
    }
  }
}

DI unsigned f2h_key(float x) {
  _Float16 h = (_Float16)x;
  unsigned u = (unsigned)__builtin_bit_cast(unsigned short, h);
  if (u == 0x8000u) u = 0u;
  return (u & 0x8000u) ? (u ^ 0xffffu) : (u | 0x8000u);
}
DI int dpp_scan_incl(int x) {
  x += __builtin_amdgcn_update_dpp(0, x, 0x111, 0xf, 0xf, true);
  x += __builtin_amdgcn_update_dpp(0, x, 0x112, 0xf, 0xf, true);
  x += __builtin_amdgcn_update_dpp(0, x, 0x114, 0xf, 0xf, true);
  x += __builtin_amdgcn_update_dpp(0, x, 0x118, 0xf, 0xf, true);
  x += __builtin_amdgcn_update_dpp(0, x, 0x142, 0xa, 0xf, false);
  x += __builtin_amdgcn_update_dpp(0, x, 0x143, 0xc, 0xf, false);
  return x;
}
constexpr int SEL_ROW = 8208;
constexpr int SEL_HIST = 4 * SEL_ROW * 2;
constexpr int SEL_HIST2 = SEL_HIST + 4 * 512 * 4;
constexpr int SEL_MISC = SEL_HIST2 + 4 * 64 * 4;

DI void phase_sel(const int wv_, const Params& p, char* smem, unsigned* ctr) {
  PHASE_IDS
  const int wave = tid_ >> 6, lane = tid_ & 63;
  u16* S = (u16*)smem;
  unsigned* hist = (unsigned*)(smem + SEL_HIST);
  unsigned* hist2 = (unsigned*)(smem + SEL_HIST2);
  int* misc = (int*)(smem + SEL_MISC);
  const int g = lane >> 4;
  const int qs = wave >> 1, t128 = (wave & 1) * 64 + lane;
  for (;;) {
    if (tid_ == 0) misc[24] = (int)atomicAdd(ctr, 1u);
    __syncthreads();
    const int item = misc[24];
    if (item >= 8000) break;
    const int b = item / 2000, qi = 1999 - (item - b * 2000), t0 = 320 + qi * 4;
    const int c = t0 >> 6, N = 64 * (c + 1) - 112, KT = N >> 4, ND = N >> 1;
    for (int i = tid_; i < 4 * 512 + 4 * 64; i += NTHR) hist[i] = 0u;
    {
      const int r16 = lane & 15, rq = r16 >> 2, rh = r16 & 3;
      const u16* rowq = p.proj + (size_t)(b * P + t0 + rq) * LD_AB + 1024 + g * 8;
      bf16x8 Af[2][2];
#pragma unroll
      for (int hq = 0; hq < 2; ++hq)
#pragma unroll
        for (int ks = 0; ks < 2; ++ks) Af[hq][ks] = *(const bf16x8*)(rowq + (hq * 4 + rh) * 64 + ks * 32);
      float w[8];
      {
        const uint4 wv4 = *(const uint4*)(p.proj + (size_t)(b * P + t0 + g) * LD_AB + 1600);
        w[0] = bflo(wv4.x) * IDX_SCALE; w[1] = bfhi(wv4.x) * IDX_SCALE; w[2] = bflo(wv4.y) * IDX_SCALE; w[3] = bfhi(wv4.y) * IDX_SCALE;
        w[4] = bflo(wv4.z) * IDX_SCALE; w[5] = bfhi(wv4.z) * IDX_SCALE; w[6] = bflo(wv4.w) * IDX_SCALE; w[7] = bfhi(wv4.w) * IDX_SCALE;
      }
      const u16* kbase = p.ikc + (size_t)(b * P + 112 + (lane & 15)) * 64 + g * 8;
      bf16x8 cur[2][2], nxt[2][2];
#pragma unroll
      for (int u = 0; u < 2; ++u) {
        int kk = wave + 8 * u; kk = kk < KT ? kk : KT - 1;
        const u16* pp = kbase + (size_t)kk * 16 * 64;
        cur[u][0] = *(const bf16x8*)pp; cur[u][1] = *(const bf16x8*)(pp + 32);
      }
      for (int kt0 = wave; kt0 < KT; kt0 += 16) {
#pragma unroll
        for (int u = 0; u < 2; ++u) {
          int kk = kt0 + 16 + 8 * u; kk = kk < KT ? kk : KT - 1;
          const u16* pp = kbase + (size_t)kk * 16 * 64;
          nxt[u][0] = *(const bf16x8*)pp; nxt[u][1] = *(const bf16x8*)(pp + 32);
        }
#pragma unroll
        for (int u = 0; u < 2; ++u) {
          const int kt = kt0 + 8 * u;
          float sc = 0.f;
#pragma unroll
          for (int hq = 0; hq < 2; ++hq) {
            f32x4 C = f32x4{0.f, 0.f, 0.f, 0.f};
            C = __builtin_amdgcn_mfma_f32_16x16x32_bf16(Af[hq][0], cur[u][0], C, 0, 0, 0);
            C = __builtin_amdgcn_mfma_f32_16x16x32_bf16(Af[hq][1], cur[u][1], C, 0, 0, 0);
#pragma unroll
            for (int j = 0; j < 4; ++j) sc = __builtin_fmaf(w[hq * 4 + j], __builtin_amdgcn_fmed3f(C[j], 0.f, __builtin_inff()), sc);
          }
          if (kt < KT) S[g * SEL_ROW + kt * 16 + (lane & 15)] = (u16)f2h_key(sc);
        }
#pragma unroll
        for (int u = 0; u < 2; ++u) { cur[u][0] = nxt[u][0]; cur[u][1] = nxt[u][1]; }
      }
    }
    __syncthreads();
    const unsigned* Srow = (const unsigned*)(S + qs * SEL_ROW);
    for (int i = t128; i < ND; i += 128) {
      unsigned kk = Srow[i];
      unsigned bA = (kk & 0xffffu) >> 6, bB = kk >> 22;
      atomicAdd(&hist[qs * 512 + (bA >> 1)], 1u << ((bA & 1) * 16));
      atomicAdd(&hist[qs * 512 + (bB >> 1)], 1u << ((bB & 1) * 16));
    }
    __syncthreads();
    int cb[8]; int csum = 0;
    {
#pragma unroll
      for (int i = 0; i < 4; ++i) {
        unsigned d = hist[qs * 512 + 511 - 4 * t128 - i];
        cb[2 * i] = (int)(d >> 16); cb[2 * i + 1] = (int)(d & 0xffffu);
        csum += cb[2 * i] + cb[2 * i + 1];
      }
    }
    int incl = dpp_scan_incl(csum);
    if (lane == 63) misc[wave] = incl;
    __syncthreads();
    if (wave & 1) incl += misc[wave - 1];
    {
      int above = incl - csum;
      if (above < 256 && 256 <= incl) {
        int cum = above, bsel = 0, Gsel = 0; bool done = false;
#pragma unroll
        for (int i = 0; i < 8; ++i) {
          if (!done) { if (cum + cb[i] >= 256) { bsel = 2 * (511 - 4 * t128 - (i >> 1)) + 1 - (i & 1); Gsel = cum; done = true; } else cum += cb[i]; }
        }
        misc[8 + 2 * qs] = bsel; misc[9 + 2 * qs] = Gsel;
      }
    }
    __syncthreads();
    const int b1 = misc[8 + 2 * qs], G1 = misc[9 + 2 * qs];
    for (int i = t128; i < ND; i += 128) {
      unsigned kk = Srow[i];
      unsigned kA = kk & 0xffffu, kB = kk >> 16;
      if ((int)(kA >> 6) == b1) atomicAdd(&hist2[qs * 64 + (kA & 63u)], 1u);
      if ((int)(kB >> 6) == b1) atomicAdd(&hist2[qs * 64 + (kB & 63u)], 1u);
    }
    __syncthreads();
    if ((wave & 1) == 0) {
      int cnt = (int)hist2[qs * 64 + 63 - lane];
      int inc2 = dpp_scan_incl(cnt);
      int ab2 = inc2 - cnt, need2 = 256 - G1;
      if (ab2 < need2 && need2 <= inc2) { misc[16 + 2 * qs] = (b1 << 6) | (63 - lane); misc[17 + 2 * qs] = G1 + ab2; }
    }
    __syncthreads();
    const unsigned T = (unsigned)misc[16 + 2 * qs]; const int G = misc[17 + 2 * qs], Rn = 256 - G;
    const int L = ((ND + 127) >> 7) | 1;
    const int i0 = t128 * L, i1 = (i0 + L < ND) ? i0 + L : ND;
    int cg_ = 0, ce_ = 0;
    for (int i = i0; i < i1; ++i) {
      unsigned kk = Srow[i];
      unsigned kA = kk & 0xffffu, kB = kk >> 16;
      cg_ += (kA > T) + (kB > T); ce_ += (kA == T) + (kB == T);
    }
    int pk = cg_ | (ce_ << 16);
    int pinc = dpp_scan_incl(pk);
    if (lane == 63) misc[wave] = pinc;
    __syncthreads();
    if (wave & 1) pinc += misc[wave - 1];
    {
      int pex = pinc - pk;
      int pg = pex & 0xffff, pe = pex >> 16;
      u16* outp = p.idx + (size_t)(b * P + t0 + qs) * 256;
      for (int i = i0; i < i1; ++i) {
        unsigned kk = Srow[i];
        unsigned kA = kk & 0xffffu, kB = kk >> 16;
        int sidx = 112 + 2 * i;
        if (kA > T) outp[pg++] = (u16)sidx; else if (kA == T) { if (pe < Rn) outp[G + pe] = (u16)sidx; ++pe; }
        if (kB > T) outp[pg++] = (u16)(sidx + 1); else if (kB == T) { if (pe < Rn) outp[G + pe] = (u16)(sidx + 1); ++pe; }
      }
    }
    __syncthreads();
  }
}

template <bool AV>
DI void att_item(const Params& p, const float* tb, const int head, const int lane, const int g, const int j, const int item) {
    const int b = item / 8208, t = 112 + (item - b * 8208);
    const int c = t >> 6, N = 64 * (c + 1) - 112;
    const int cnt = N < 256 ? N : 256;
    constexpr bool allvalid = AV;
    const u16* prow = p.proj + (size_t)(b * P + t) * LD_AB;
    const uint4 qv = *(const uint4*)(prow + head * 64 + j * 8);
    const uint4 gv = *(const uint4*)(prow + 512 + head * 64 + j * 8);
    const uint4* ip = (const uint4*)(p.idx + (size_t)(b * P + t) * 256 + g * 32);
    auto get_iv = [&](int ch) -> uint4 {
      uint4 v;
      if (N > 256) { v = ip[ch]; }
      else {
        unsigned wv[4];
#pragma unroll
        for (int w2 = 0; w2 < 4; ++w2) {
          int i0 = g * 32 + ch * 8 + 2 * w2, i1 = i0 + 1;
          unsigned s0 = 112 + (i0 < N ? i0 : 0), s1 = 112 + (i1 < N ? i1 : 0);
          wv[w2] = s0 | (s1 << 16);
        }
        v = make_uint4(wv[0], wv[1], wv[2], wv[3]);
      }
      return v;
    };
    const u16* kcol = p.kc + ((size_t)(b * 8 + head) * P) * 64 + j * 8;
    const u16* vcol = p.vc + ((size_t)(b * 8 + head) * P) * 64 + j * 8;
    float m = -1e30f, l = 0.f;
    float acc[8] = {0.f, 0.f, 0.f, 0.f, 0.f, 0.f, 0.f, 0.f};
    uint4 ivn = get_iv(0);
#pragma unroll 2
    for (int ch = 0; ch < 4; ++ch) {
      const uint4 iv4 = ivn;
      ivn = get_iv(ch < 3 ? ch + 1 : 3);
      const unsigned ivw[4] = {iv4.x, iv4.y, iv4.z, iv4.w};
      uint4 kv[8], va4[4], vb4[4];
      unsigned sidx[8];
#pragma unroll
      for (int e = 0; e < 8; ++e) {
        sidx[e] = (ivw[e >> 1] >> (16 * (e & 1))) & 0xffffu;
        kv[e] = *(const uint4*)(kcol + (size_t)sidx[e] * 64);
      }
#pragma unroll
      for (int e = 0; e < 4; ++e) va4[e] = *(const uint4*)(vcol + (size_t)sidx[e] * 64);
      float dd[8]; bool vld[8];
#pragma unroll
      for (int e = 0; e < 8; ++e) {
        int ni = t - (int)sidx[e]; ni = (ni > 127 ? 127 : ni) + 63;
        const float bias = tb[ni];
        float d = dot2bf(kv[e].x, qv.x, bias);
        d = dot2bf(kv[e].y, qv.y, d); d = dot2bf(kv[e].z, qv.z, d); d = dot2bf(kv[e].w, qv.w, d);
        d += dpp_xor1(d); d += dpp_xor2(d); d += dpp_hmir(d);
        vld[e] = allvalid || ((g * 32 + ch * 8 + e) < cnt);
        dd[e] = vld[e] ? d * 0.125f : -1e30f;
      }
#pragma unroll
      for (int e = 0; e < 4; ++e) vb4[e] = *(const uint4*)(vcol + (size_t)sidx[4 + e] * 64);
      float mn = fmaxf(fmaxf(fmaxf(dd[0], dd[1]), fmaxf(dd[2], dd[3])), fmaxf(fmaxf(dd[4], dd[5]), fmaxf(dd[6], dd[7])));
      mn = fmaxf(mn, m);
      const float scl = __expf(m - mn);
      m = mn;
      l *= scl;
#pragma unroll
      for (int i = 0; i < 8; ++i) acc[i] *= scl;
#pragma unroll
      for (int pr = 0; pr < 4; ++pr) {
        float p0 = vld[2 * pr] ? __expf(dd[2 * pr] - mn) : 0.f;
        float p1 = vld[2 * pr + 1] ? __expf(dd[2 * pr + 1] - mn) : 0.f;
        l += p0 + p1;
        const unsigned pp = pack2(p0, p1);
        const uint4 va = pr < 2 ? va4[2 * pr] : vb4[2 * pr - 4], vb = pr < 2 ? va4[2 * pr + 1] : vb4[2 * pr - 3];
        acc[0] = dot2bf(__builtin_amdgcn_perm(vb.x, va.x, 0x05040100u), pp, acc[0]);
        acc[1] = dot2bf(__builtin_amdgcn_perm(vb.x, va.x, 0x07060302u), pp, acc[1]);
        acc[2] = dot2bf(__builtin_amdgcn_perm(vb.y, va.y, 0x05040100u), pp, acc[2]);
        acc[3] = dot2bf(__builtin_amdgcn_perm(vb.y, va.y, 0x07060302u), pp, acc[3]);
        acc[4] = dot2bf(__builtin_amdgcn_perm(vb.z, va.z, 0x05040100u), pp, acc[4]);
        acc[5] = dot2bf(__builtin_amdgcn_perm(vb.z, va.z, 0x07060302u), pp, acc[5]);
        acc[6] = dot2bf(__builtin_amdgcn_perm(vb.w, va.w, 0x05040100u), pp, acc[6]);
        acc[7] = dot2bf(__builtin_amdgcn_perm(vb.w, va.w, 0x07060302u), pp, acc[7]);
      }
    }
    float M = fmaxf(m, dpp_ror8(m)); M = fmaxf(M, shx(M, lane, 16)); M = fmaxf(M, shx(M, lane, 32));
    float f = __expf(m - M);
    l *= f;
    l += dpp_ror8(l); l += shx(l, lane, 16); l += shx(l, lane, 32);
#pragma unroll
    for (int i = 0; i < 8; ++i) { acc[i] *= f; acc[i] += dpp_ror8(acc[i]); acc[i] += shx(acc[i], lane, 16); acc[i] += shx(acc[i], lane, 32); }
    if (g == 0) {
      float inv = 1.f / l;
      uint4 o;
      o.x = pack2(acc[0] * inv * silu(bflo(gv.x)), acc[1] * inv * silu(bfhi(gv.x)));
      o.y = pack2(acc[2] * inv * silu(bflo(gv.y)), acc[3] * inv * silu(bfhi(gv.y)));
      o.z = pack2(acc[4] * inv * silu(bflo(gv.z)), acc[5] * inv * silu(bfhi(gv.z)));
      o.w = pack2(acc[6] * inv * silu(bflo(gv.w)), acc[7] * inv * silu(bfhi(gv.w)));
      *(uint4*)(p.hn + (size_t)(b * P + t) * 1024 + head * 64 + j * 8) = o;
    }
}

DI void phase_att(const int wv_, const Params& p, char* smem, unsigned* ctr, const int head) {
  PHASE_IDS
  float* tb = (float*)smem;
  __syncthreads();
  if (tid_ < 191) {
    int n = tid_ - 63; int ret = n < 0 ? 16 : 0; n = n < 0 ? -n : n;
    int large = 2 + 31 - __clz(n * n | 1); large = large > 15 ? 15 : large;
    tb[tid_] = p.rel_bias[(ret + (n < 8 ? n : large)) * 8 + head];
  }
  __syncthreads();
  const int wave = tid_ >> 6, lane = tid_ & 63;
  const int g = lane >> 3, j = lane & 7;
  for (;;) {
    int ibase = 0;
    if (lane == 0) ibase = (int)atomicAdd(ctr + head, 8u);
    ibase = __builtin_amdgcn_readfirstlane(ibase);
    if (ibase >= 4 * 8208) break;
#pragma unroll 1
  for (int item = ibase; item < ibase + 8; ++item) {
    if (112 + (item % 8208) >= 320) att_item<true>(p, tb, head, lane, g, j, item); else att_item<false>(p, tb, head, lane, g, j, item);
  }
  }
}

DI float logsigmoidf(float x) { return fminf(x, 0.f) - __logf(1.f + __expf(-fabsf(x))); }

DI float rot_val(const u16* base, int d, int pos) {
  int d2 = d & 31;
  float x1 = bf2f(base[d2]), x2 = bf2f(base[32 + d2]);
  float inv = exp2f(-(float)d2 * (13.287712379549449f / 32.f));
  float ang = (float)pos * inv;
  float sn = sinf(ang), cs = cosf(ang);
  return d < 32 ? x1 * cs - x2 * sn : x1 * sn + x2 * cs;
}

template <int RET>
DI float compute_bcum(const int wv_, const Params& p, int lj, int b, int h, int n, float* bc, float* tot) {
  PHASE_IDS
  const int d = tid_ & 63, w = tid_ >> 6;
  float la[8];
  if (RET) {
    float lgam = logf(1.f - exp2f(-5.f - (float)h));
#pragma unroll
    for (int i = 0; i < 8; ++i) la[i] = lgam;
  } else {
    const float* W2 = p.gate_w2 + (size_t)lj * 16 * 256 + h * 64 + d;
    float wr[16];
#pragma unroll
    for (int r = 0; r < 16; ++r) wr[r] = W2[r * 256];
    float gb = p.gate_b[lj * 256 + h * 64 + d];
#pragma unroll
    for (int i = 0; i < 8; ++i) {
      const u16* ba = p.proj + (size_t)(b * P + n * 64 + 8 * w + i) * LD_AB + 3144;
      uint4 u0 = *(const uint4*)ba, u1 = *(const uint4*)(ba + 8);
      float x = gb;
      x += bflo(u0.x) * wr[0] + bfhi(u0.x) * wr[1] + bflo(u0.y) * wr[2] + bfhi(u0.y) * wr[3];
      x += bflo(u0.z) * wr[4] + bfhi(u0.z) * wr[5] + bflo(u0.w) * wr[6] + bfhi(u0.w) * wr[7];
      x += bflo(u1.x) * wr[8] + bfhi(u1.x) * wr[9] + bflo(u1.y) * wr[10] + bfhi(u1.y) * wr[11];
      x += bflo(u1.z) * wr[12] + bfhi(u1.z) * wr[13] + bflo(u1.w) * wr[14] + bfhi(u1.w) * wr[15];
      la[i] = logsigmoidf(x) * (1.f / 16.f);
    }
  }
  float run = 0.f;
#pragma unroll
  for (int i = 0; i < 8; ++i) { run += la[i]; la[i] = run; }
  tot[w * 64 + d] = run;
  __syncthreads();
  float off = 0.f, bl = 0.f;
#pragma unroll
  for (int w2 = 0; w2 < 8; ++w2) { float v = tot[w2 * 64 + d]; if (w2 < w) off += v; bl += v; }
#pragma unroll
  for (int i = 0; i < 8; ++i) bc[(8 * w + i) * 64 + d] = off + la[i];
  __syncthreads();
  return bl;
}

constexpr int GR = 5, NRUN = 26;
constexpr int G_QT = 16384, G_KT = G_QT + 9216, G_KP = G_KT + 9216, G_VT = G_KP + 9216, G_TOT = G_VT + 18432,
              G_RED = G_TOT + 2048, G_DEC = G_RED + 4096, G_BL = G_DEC + 256, G_ST = G_BL + 256;

DI bf16x8 pack8(const f32x4& a, const f32x4& b) {
  uint4 r; r.x = pack2(a[0], a[1]); r.y = pack2(a[2], a[3]); r.z = pack2(b[0], b[1]); r.w = pack2(b[2], b[3]);
  return __builtin_bit_cast(bf16x8, r);
}
DI bf16x8 ld_b64x2(const u16* lo, const u16* hi) {
  uint2 a = *(const uint2*)lo, b = *(const uint2*)hi;
  return __builtin_bit_cast(bf16x8, make_uint4(a.x, a.y, b.x, b.y));
}

template <int RET, bool FULL>
DI void phase_gla(const int wv_, const Params& p, int lj, char* smem) {
  PHASE_IDS
  float* bc = (float*)smem;
  u16* QT = (u16*)(smem + G_QT); u16* KT = (u16*)(smem + G_KT); u16* KP = (u16*)(smem + G_KP); u16* VT = (u16*)(smem + G_VT);
  float* tot = (float*)(smem + G_TOT); float* red = (float*)(smem + G_RED); float* decs = (float*)(smem + G_DEC);
  float* stt = (float*)(smem + G_ST);
  const int LD = RET ? LD_CD : LD_AB;
  const int lane = tid_ & 63, w = tid_ >> 6, r16 = lane & 15, g = lane >> 4;
  const int sc_ = tid_ >> 3, sdc = (tid_ & 7) * 8;
  const int scw = (((sc_ >> 3) ^ (tid_ & 7)) << 3) + (sc_ & 7);
  for (int item = bid_; item < 16 * NRUN; item += nblk_) {
    const int run = item % NRUN, bh = item / NRUN, h = bh & 3, b = bh >> 2;
    f32x4 Sreg[4];
#pragma unroll
    for (int dt = 0; dt < 4; ++dt) Sreg[dt] = f32x4{0.f, 0.f, 0.f, 0.f};
    float sumbl = 0.f;
    if (FULL) {
#pragma unroll 2
      for (int r2 = 0; r2 < run; ++r2) {
        const float4* cp = (const float4*)(p.runc + (((size_t)(bh * NRUN + r2) * 8 + w) * 64 + lane) * 16);
        const float4* dp = (const float4*)(p.rund + (size_t)(bh * NRUN + r2) * 64 + g * 16);
#pragma unroll
        for (int dt = 0; dt < 4; ++dt) {
          float4 cv = cp[dt], dv = dp[dt];
          Sreg[dt][0] = Sreg[dt][0] * dv.x + cv.x; Sreg[dt][1] = Sreg[dt][1] * dv.y + cv.y;
          Sreg[dt][2] = Sreg[dt][2] * dv.z + cv.z; Sreg[dt][3] = Sreg[dt][3] * dv.w + cv.w;
        }
      }
    }
    for (int ci = 0; ci < GR; ++ci) {
      const int n = run * GR + ci;
      float blast, lgam = 0.f;
      if (RET) {
        lgam = logf(1.f - exp2f(-5.f - (float)h));
        blast = 64.f * lgam;
        if (!FULL) __syncthreads();
      } else {
        blast = compute_bcum<RET>(wv_, p, lj, b, h, n, bc, tot);
        if (w == 0) decs[lane] = __expf(blast);
      }
      sumbl += blast;
#pragma unroll 1
      for (int hf = 0; hf < 2; ++hf) {
        const int pos = n * 64 + sc_;
        const int dd = sdc + 4 * hf;
        const u16* row = p.proj + (size_t)(b * P + pos) * LD;
        float kf[4], qf[4];
        if (RET) {
          const int d2 = dd & 31;
          const float4 cs = *(const float4*)(p.tcos + pos * 32 + d2), sn = *(const float4*)(p.tsin + pos * 32 + d2);
          const float csa[4] = {cs.x, cs.y, cs.z, cs.w}, sna[4] = {sn.x, sn.y, sn.z, sn.w};
          {
            const uint2 a = *(const uint2*)(row + 256 + h * 64 + d2), bb = *(const uint2*)(row + 256 + h * 64 + 32 + d2);
            const float x1[4] = {bflo(a.x), bfhi(a.x), bflo(a.y), bfhi(a.y)}, x2[4] = {bflo(bb.x), bfhi(bb.x), bflo(bb.y), bfhi(bb.y)};
#pragma unroll
            for (int i = 0; i < 4; ++i) kf[i] = dd < 32 ? x1[i] * csa[i] - x2[i] * sna[i] : x1[i] * sna[i] + x2[i] * csa[i];
          }
          if (FULL) {
            const uint2 a = *(const uint2*)(row + h * 64 + d2), bb = *(const uint2*)(row + h * 64 + 32 + d2);
            const float x1[4] = {bflo(a.x), bfhi(a.x), bflo(a.y), bfhi(a.y)}, x2[4] = {bflo(bb.x), bfhi(bb.x), bflo(bb.y), bfhi(bb.y)};
#pragma unroll
            for (int i = 0; i < 4; ++i) qf[i] = dd < 32 ? x1[i] * csa[i] - x2[i] * sna[i] : x1[i] * sna[i] + x2[i] * csa[i];
          }
        } else {
          const uint2 a = *(const uint2*)(row + 1864 + h * 64 + dd);
          kf[0] = bflo(a.x); kf[1] = bfhi(a.x); kf[2] = bflo(a.y); kf[3] = bfhi(a.y);
          if (FULL) {
            const uint2 q2 = *(const uint2*)(row + 1608 + h * 64 + dd);
            qf[0] = bflo(q2.x); qf[1] = bfhi(q2.x); qf[2] = bflo(q2.y); qf[3] = bfhi(q2.y);
          }
        }
        const u16* vr = row + (RET ? 512 : 2120) + h * 128 + dd;
        const uint2 v0 = *(const uint2*)vr, v1 = *(const uint2*)(vr + 64);
        float ev[4], bl[4];
        if (RET) {
          const float e0_ = (float)(sc_ + 1) * lgam;
          ev[0] = ev[1] = ev[2] = ev[3] = e0_; bl[0] = bl[1] = bl[2] = bl[3] = blast;
        } else {
          const float4 ev4 = *(const float4*)(bc + sc_ * 64 + dd), bl4 = *(const float4*)(bc + 63 * 64 + dd);
          ev[0] = ev4.x; ev[1] = ev4.y; ev[2] = ev4.z; ev[3] = ev4.w; bl[0] = bl4.x; bl[1] = bl4.y; bl[2] = bl4.z; bl[3] = bl4.w;
        }
        if (FULL) {
          uint2 o1, o2;
          o1.x = pack2(qf[0] * 0.125f * __expf(ev[0]), qf[1] * 0.125f * __expf(ev[1])); o1.y = pack2(qf[2] * 0.125f * __expf(ev[2]), qf[3] * 0.125f * __expf(ev[3]));
          o2.x = pack2(kf[0] * __expf(-ev[0]), kf[1] * __expf(-ev[1])); o2.y = pack2(kf[2] * __expf(-ev[2]), kf[3] * __expf(-ev[3]));
          *(uint2*)(QT + sc_ * 72 + dd) = o1; *(uint2*)(KT + sc_ * 72 + dd) = o2;
        }
#pragma unroll
        for (int i = 0; i < 4; ++i) {
          float kp = kf[i] * __expf(bl[i] - ev[i]);
          KP[(dd + i) * 72 + scw] = (u16)(pack2(kp, 0.f) & 0xffffu);
        }
        VT[(dd + 0) * 72 + scw] = (u16)(v0.x & 0xffffu); VT[(dd + 1) * 72 + scw] = (u16)(v0.x >> 16);
        VT[(dd + 2) * 72 + scw] = (u16)(v0.y & 0xffffu); VT[(dd + 3) * 72 + scw] = (u16)(v0.y >> 16);
        VT[(64 + dd + 0) * 72 + scw] = (u16)(v1.x & 0xffffu); VT[(64 + dd + 1) * 72 + scw] = (u16)(v1.x >> 16);
        VT[(64 + dd + 2) * 72 + scw] = (u16)(v1.y & 0xffffu); VT[(64 + dd + 3) * 72 + scw] = (u16)(v1.y >> 16);
      }
      __syncthreads();
      const int tl_ = lnd_v(tid_);
      const int r16 = tl_ & 15, g = (tl_ >> 4) & 3, w = tl_ >> 6;
      f32x4 o[4];
      if (FULL) {
#pragma unroll
        for (int ct = 0; ct < 4; ++ct) o[ct] = f32x4{0.f, 0.f, 0.f, 0.f};
#pragma unroll
        for (int kk = 0; kk < 2; ++kk) {
          const bf16x8 Bs = pack8(Sreg[2 * kk], Sreg[2 * kk + 1]);
#pragma unroll
          for (int ct = 0; ct < 4; ++ct) {
            const u16* qp = QT + (16 * ct + r16) * 72 + 32 * kk + 4 * g;
            o[ct] = __builtin_amdgcn_mfma_f32_16x16x32_bf16(ld_b64x2(qp, qp + 16), Bs, o[ct], 0, 0, 0);
          }
        }
#pragma unroll
        for (int ct = 0; ct < 4; ++ct) {
          const bf16x8 Bq0 = *(const bf16x8*)(QT + (16 * ct + r16) * 72 + 8 * g), Bq1 = *(const bf16x8*)(QT + (16 * ct + r16) * 72 + 32 + 8 * g);
          f32x4 at[4];
#pragma unroll
          for (int st = 0; st < 4; ++st) {
            at[st] = f32x4{0.f, 0.f, 0.f, 0.f};
            if (st <= ct) {
              const bf16x8 A0 = *(const bf16x8*)(KT + (16 * st + r16) * 72 + 8 * g), A1 = *(const bf16x8*)(KT + (16 * st + r16) * 72 + 32 + 8 * g);
              f32x4 acc = f32x4{0.f, 0.f, 0.f, 0.f};
              acc = __builtin_amdgcn_mfma_f32_16x16x32_bf16(A0, Bq0, acc, 0, 0, 0);
              acc = __builtin_amdgcn_mfma_f32_16x16x32_bf16(A1, Bq1, acc, 0, 0, 0);
              if (st == ct) {
#pragma unroll
                for (int j = 0; j < 4; ++j) acc[j] = (4 * g + j <= r16) ? acc[j] : 0.f;
              }
              at[st] = acc;
            }
          }
#pragma unroll
          for (int m = 0; m < 2; ++m) {
            if (2 * m <= ct) {
              const bf16x8 Aa = pack8(at[2 * m], at[2 * m + 1]);
              const int swv = (2 * w + (r16 >> 3)) & 7;
              const u16* vrow = VT + (16 * w + r16) * 72 + 4 * (g & 1);
              o[ct] = __builtin_amdgcn_mfma_f32_16x16x32_bf16(Aa, ld_b64x2(vrow + (((4 * m + (g >> 1)) ^ swv) << 3), vrow + (((4 * m + 2 + (g >> 1)) ^ swv) << 3)), o[ct], 0, 0, 0);
            }
          }
        }
      }
      {
        const int swb = (2 * w + (r16 >> 3)) & 7;
        const bf16x8 Bv0 = *(const bf16x8*)(VT + (16 * w + r16) * 72 + ((g ^ swb) << 3)), Bv1 = *(const bf16x8*)(VT + (16 * w + r16) * 72 + (((4 + g) ^ swb) << 3));
#pragma unroll
        for (int dt = 0; dt < 4; ++dt) {
          float4 dv;
          if (RET) { const float dc_ = __expf(blast); dv = make_float4(dc_, dc_, dc_, dc_); }
          else dv = *(const float4*)(decs + 16 * dt + 4 * g);
          f32x4 acc = f32x4{Sreg[dt][0] * dv.x, Sreg[dt][1] * dv.y, Sreg[dt][2] * dv.z, Sreg[dt][3] * dv.w};
          const int swa = (2 * dt + (r16 >> 3)) & 7;
          const bf16x8 A0 = *(const bf16x8*)(KP + (16 * dt + r16) * 72 + ((g ^ swa) << 3)), A1 = *(const bf16x8*)(KP + (16 * dt + r16) * 72 + (((4 + g) ^ swa) << 3));
          acc = __builtin_amdgcn_mfma_f32_16x16x32_bf16(A0, Bv0, acc, 0, 0, 0);
          acc = __builtin_amdgcn_mfma_f32_16x16x32_bf16(A1, Bv1, acc, 0, 0, 0);
          Sreg[dt] = acc;
        }
      }
      if (FULL) {
        const int gcol = (RET ? 1024 : 2632) + h * 128 + 16 * w + r16, ocol = (RET ? 0 : 512) + h * 128 + 16 * w + r16;
        u16 gq[16];
#pragma unroll
        for (int ct = 0; ct < 4; ++ct)
#pragma unroll
          for (int j = 0; j < 4; ++j) gq[ct * 4 + j] = p.proj[(unsigned)(b * P + n * 64 + 16 * ct + 4 * g + j) * (unsigned)LD + (unsigned)gcol];
#pragma unroll
        for (int ct = 0; ct < 4; ++ct)
#pragma unroll
          for (int j = 0; j < 4; ++j) {
            float s2 = o[ct][j] * o[ct][j], s1 = o[ct][j];
            s2 += dpp_xor1(s2); s2 += dpp_xor2(s2); s2 += dpp_hmir(s2); s2 += dpp_ror8(s2);
            if (RET) { s1 += dpp_xor1(s1); s1 += dpp_xor2(s1); s1 += dpp_hmir(s1); s1 += dpp_ror8(s1); }
            if (r16 == 0) { red[w * 64 + 16 * ct + 4 * g + j] = s2; if (RET) red[512 + w * 64 + 16 * ct + 4 * g + j] = s1; }
          }
        __syncthreads();
        if (tid_ < 64) {
          float t2 = 0.f, t1 = 0.f;
#pragma unroll
          for (int w2 = 0; w2 < 8; ++w2) { t2 += red[w2 * 64 + tid_]; if (RET) t1 += red[512 + w2 * 64 + tid_]; }
          float mean = RET ? t1 * (1.f / 128.f) : 0.f;
          float var = t2 * (1.f / 128.f) - mean * mean;
          stt[tid_] = rsqrtf(fmaxf(var, 0.f) + 1e-6f); stt[64 + tid_] = mean;
        }
        __syncthreads();
#pragma unroll
        for (int ct = 0; ct < 4; ++ct)
#pragma unroll
          for (int j = 0; j < 4; ++j) {
            const int c = 16 * ct + 4 * g + j;
            const unsigned R = (unsigned)(b * P + n * 64 + c);
            const float gate = bf2f(gq[ct * 4 + j]);
            const float val = (o[ct][j] - stt[64 + c]) * stt[c] * silu(gate);
            p.hn[R * 1024u + (unsigned)ocol] = (u16)(pack2(val, 0.f) & 0xffffu);
          }
      }
    }
    if (!FULL) {
      float* cp = p.runc + (((size_t)(bh * NRUN + run) * 8 + w) * 64 + lane) * 16;
#pragma unroll
      for (int dt = 0; dt < 4; ++dt) *(float4*)(cp + 4 * dt) = make_float4(Sreg[dt][0], Sreg[dt][1], Sreg[dt][2], Sreg[dt][3]);
      if (w == 0) { const int d = lane; p.rund[(size_t)(bh * NRUN + run) * 64 + ((d >> 2) & 3) * 16 + (d >> 4) * 4 + (d & 3)] = expf(sumbl); }
    }
    __syncthreads();
  }
}

DI void phase_sb(const int wv_, const Params& p) {
  PHASE_IDS
  const int wave = tid_ >> 6, lane = tid_ & 63;
  const int r = lane & 15, g = lane >> 4;
  const int gw = bid_ * 8 + wave, nw = nblk_ * 8;
  for (int item = gw; item < 4 * 8 * 513; item += nw) {
    const int rti = item % 513, h = (item / 513) & 7, b = item / (513 * 8);
    const int t0 = 112 + rti * 16, tq = t0 + r;
    const u16* qrow = p.proj + (size_t)(b * P + tq) * LD_CD + 1536 + h * 64 + g * 8;
    const bf16x8 qf0 = *(const bf16x8*)qrow, qf1 = *(const bf16x8*)(qrow + 32);
    f32x4 o[4];
#pragma unroll
    for (int i = 0; i < 4; ++i) o[i] = f32x4{0.f, 0.f, 0.f, 0.f};
    float A = 0.f;
    const u16* vtb = p.vt + (size_t)((b * 8 + h) * 64) * P;
    for (int kb = t0 & ~31; kb >= 96; kb -= 32) {
      f32x4 z[2];
#pragma unroll
      for (int blk = 0; blk < 2; ++blk) {
        const u16* kr = p.proj + (size_t)(b * P + kb + 16 * blk + r) * LD_CD + 2048 + h * 64 + g * 8;
        bf16x8 a0 = *(const bf16x8*)kr, a1 = *(const bf16x8*)(kr + 32);
        f32x4 zz = f32x4{0.f, 0.f, 0.f, 0.f};
        zz = __builtin_amdgcn_mfma_f32_16x16x32_bf16(a0, qf0, zz, 0, 0, 0);
        zz = __builtin_amdgcn_mfma_f32_16x16x32_bf16(a1, qf1, zz, 0, 0, 0);
        z[blk] = zz;
      }
      float L[2][4], lsg[2][4]; bool ok[2][4];
      float T0 = 0.f, T1 = 0.f;
#pragma unroll
      for (int blk = 0; blk < 2; ++blk)
#pragma unroll
        for (int j = 0; j < 4; ++j) {
          int s = kb + 16 * blk + 4 * g + j;
          float zv = z[blk][j] * 0.125f;
          bool okk = (s < tq) && (s >= 112);
          float tl = __logf(1.f + __expf(-fabsf(zv)));
          float sp = fmaxf(zv, 0.f) + tl;
          L[blk][j] = okk ? -sp : 0.f;
          lsg[blk][j] = fminf(zv, 0.f) - tl;
          ok[blk][j] = okk;
        }
#pragma unroll
      for (int j = 0; j < 4; ++j) { T0 += L[0][j]; T1 += L[1][j]; }
      float x1 = shx(T1, lane, 16), a1s = T1 + x1, po1 = shx(a1s, lane, 32), tot1 = a1s + po1;
      float hi1 = ((g & 1) == 0 ? x1 : 0.f) + ((g & 2) == 0 ? po1 : 0.f);
      float x0 = shx(T0, lane, 16), a0s = T0 + x0, po0 = shx(a0s, lane, 32), tot0 = a0s + po0;
      float hi0 = ((g & 1) == 0 ? x0 : 0.f) + ((g & 2) == 0 ? po0 : 0.f);
      float w1[4], w0[4];
      float run = A + hi1;
#pragma unroll
      for (int j = 3; j >= 0; --j) { w1[j] = ok[1][j] ? __expf(lsg[1][j] + run) : 0.f; run += L[1][j]; }
      run = A + tot1 + hi0;
#pragma unroll
      for (int j = 3; j >= 0; --j) { w0[j] = ok[0][j] ? __expf(lsg[0][j] + run) : 0.f; run += L[0][j]; }
      uint4 wp; wp.x = pack2(w0[0], w0[1]); wp.y = pack2(w0[2], w0[3]); wp.z = pack2(w1[0], w1[1]); wp.w = pack2(w1[2], w1[3]);
      bf16x8 wfrag = __builtin_bit_cast(bf16x8, wp);
#pragma unroll
      for (int eb = 0; eb < 4; ++eb) {
        const u16* vp = vtb + (size_t)(eb * 16 + r) * P + kb + 4 * g;
        uint2 lo = *(const uint2*)vp, hi = *(const uint2*)(vp + 16);
        uint4 vv = make_uint4(lo.x, lo.y, hi.x, hi.y);
        o[eb] = __builtin_amdgcn_mfma_f32_16x16x32_bf16(__builtin_bit_cast(bf16x8, vv), wfrag, o[eb], 0, 0, 0);
      }
      A += tot1 + tot0;
      if (__all(A < -104.f)) break;
    }
    const u16* grow = p.proj + (size_t)(b * P + tq) * LD_CD + 3072 + h * 64;
    u16* orow = p.hn + (size_t)(b * P + tq) * 1024 + 512 + h * 64;
#pragma unroll
    for (int eb = 0; eb < 4; ++eb) {
      int e = eb * 16 + 4 * g;
      uint2 gv = *(const uint2*)(grow + e);
      uint2 ov;
      ov.x = pack2(o[eb][0] * silu(bflo(gv.x)), o[eb][1] * silu(bfhi(gv.x)));
      ov.y = pack2(o[eb][2] * silu(bflo(gv.y)), o[eb][3] * silu(bfhi(gv.y)));
      *(uint2*)(orow + e) = ov;
    }
  }
}

DI void phase_final(const int wv_, const Params& p) {
  PHASE_IDS
  const int wave = tid_ >> 6, lane = tid_ & 63;
  for (int R = bid_ * 8 + wave; R < NB * SEQ; R += nblk_ * 8) {
    float4* row = (float4*)(p.out + (size_t)R * 1024);
    float4 v[4]; float ss = 0.f;
#pragma unroll
    for (int i = 0; i < 4; ++i) { v[i] = row[lane + i * 64]; ss += v[i].x * v[i].x + v[i].y * v[i].y + v[i].z * v[i].z + v[i].w * v[i].w; }
#pragma unroll
    for (int o = 32; o >= 1; o >>= 1) ss += shx(ss, lane, o);
    float sc = rsqrtf(ss * (1.f / 1024.f) + 1e-6f);
#pragma unroll
    for (int i = 0; i < 4; ++i) {
      float4 gg = ((const float4*)p.final_g)[lane + i * 64];
      row[lane + i * 64] = make_float4(v[i].x * sc * gg.x, v[i].y * sc * gg.y, v[i].z * sc * gg.z, v[i].w * sc * gg.w);
    }
  }
}

#define XB_TMO      128
#define XB_XCNT(j)  (256  + 64 * (j))
#define XB_XSUB(j)  (1280 + 64 * (j))
#define XB_XGEN(j)  (2304 + 64 * (j))
#define XB_TOP      3328
#define XB_TOPGEN   3392
#define XCD_BAR_WORDS 3456
#define XB_SPIN_CAP (1u << 22)
DI unsigned xb_ld(unsigned* p) { return __hip_atomic_load(p, __ATOMIC_RELAXED, __HIP_MEMORY_SCOPE_AGENT); }
DI unsigned xb_add(unsigned* p, unsigned v) { return __hip_atomic_fetch_add(p, v, __ATOMIC_RELAXED, __HIP_MEMORY_SCOPE_AGENT); }
DI unsigned xb_xcc_id() { return (unsigned)__builtin_amdgcn_s_getreg((3 << 11) | 20) & 0xFu; }
#define XB_SPIN(cond, bar) do { unsigned _sp = 0; while (cond) { __builtin_amdgcn_s_sleep(1); \
    if ((++_sp & 255u) == 0u) { if (xb_ld(&(bar)[XB_TMO])) break; if (_sp > XB_SPIN_CAP) { atomicAdd(&(bar)[XB_TMO], 1u); break; } } } } while (0)

DI void xcd_barrier_complete(unsigned* bar, unsigned x, unsigned G, unsigned& nloc, unsigned& nx, unsigned& popmask) {
  unsigned sum, cnt, mine, pm, sp = 0u;
  for (;;) {
    sum = 0u; cnt = 0u; mine = 0u; pm = 0u;
#pragma unroll
    for (unsigned j = 0; j < 16; ++j) { const unsigned c = xb_ld(&bar[XB_XCNT(j)]); sum += c; cnt += (c > 0u) ? 1u : 0u; pm |= (c > 0u) ? (1u << j) : 0u; mine = (j == x) ? c : mine; }
    if (sum == G) break;
    __builtin_amdgcn_s_sleep(1);
    if ((++sp & 255u) == 0u) { if (xb_ld(&bar[XB_TMO])) break; if (sp > XB_SPIN_CAP) { atomicAdd(&bar[XB_TMO], 1u); break; } }
  }
  nloc = mine > 0u ? mine : 1u; nx = cnt > 0u ? cnt : 1u; popmask = pm;
}

DI void grid_bar(const int wv_, unsigned* bar, const unsigned x, const unsigned nloc, const unsigned nx, unsigned& gen) {
  PHASE_IDS
  asm volatile("s_waitcnt vmcnt(0)" ::: "memory");
  __syncthreads();
  if (tid_ == 0) {
    __builtin_amdgcn_s_waitcnt(0);
    const unsigned old = xb_add(&bar[XB_XSUB(x)], 1u);
    if (old + 1u == (gen + 1u) * nloc) {
      __builtin_amdgcn_fence(__ATOMIC_RELEASE, "agent");
      asm volatile("s_waitcnt vmcnt(0)" ::: "memory");
      const unsigned og = xb_add(&bar[XB_TOP], 1u);
      if (og + 1u == (gen + 1u) * nx) xb_add(&bar[XB_TOPGEN], 1u);
      else { while (xb_ld(&bar[XB_TOPGEN]) == gen) __builtin_amdgcn_s_sleep(1); }
      __builtin_amdgcn_fence(__ATOMIC_ACQUIRE, "agent");
      xb_add(&bar[XB_XGEN(x)], 1u);
      asm volatile("s_waitcnt vmcnt(0)" ::: "memory");
    } else {
      while (xb_ld(&bar[XB_XGEN(x)]) == gen) __builtin_amdgcn_s_sleep(1);
      __builtin_amdgcn_fence(__ATOMIC_ACQUIRE, "agent");
      asm volatile("s_waitcnt vmcnt(0)" ::: "memory");
    }
  }
  __syncthreads();
  gen = (unsigned)__builtin_amdgcn_readfirstlane((int)(gen + 1u));
}

__global__ void __launch_bounds__(NTHR, 4) mega(Params p) {
  __shared__ __attribute__((aligned(16))) char smem[SMEM_BYTES];
  cg::grid_group grid = cg::this_grid();
  const int wv_ = __builtin_amdgcn_readfirstlane((int)threadIdx.x >> 6);
  unsigned gen = 0u;
  {
    const int t0_ = wv_ * 64 + (int)__builtin_amdgcn_mbcnt_hi(~0u, __builtin_amdgcn_mbcnt_lo(~0u, 0u));
    if (t0_ == 0) {
      volatile unsigned* st = (volatile unsigned*)(smem + SMEM_BYTES - 32);
      const unsigned x = xb_xcc_id();
      st[0] = 0u; st[1] = 0u; st[2] = x;
      (void)xb_add(&p.bar[XB_XCNT(x)], 1u);
    }
    __syncthreads();
  }
  REP(8) phase_prep(wv_, p);
  grid.sync();
  unsigned xcc_, nloc_, nx_; int ahead_;
  {
    volatile unsigned* st = (volatile unsigned*)(smem + SMEM_BYTES - 32);
    const int t0_ = wv_ * 64 + (int)__builtin_amdgcn_mbcnt_hi(~0u, __builtin_amdgcn_mbcnt_lo(~0u, 0u));
    if (t0_ == 0) {
      unsigned nloc = 0u, nx = 0u, pm = 0u;
      xcd_barrier_complete(p.bar, st[2], gridDim.x, nloc, nx, pm);
      st[0] = nloc; st[1] = nx; st[3] = pm;
    }
    __syncthreads();
    nloc_ = __builtin_amdgcn_readfirstlane(st[0]); nx_ = __builtin_amdgcn_readfirstlane(st[1]); xcc_ = __builtin_amdgcn_readfirstlane(st[2]);
    ahead_ = (__builtin_amdgcn_readfirstlane(st[3]) == 0xFFu) ? (int)(xcc_ & 7u) : (int)(blockIdx.x & 7u);
    __syncthreads();
  }
  for (int layer = 0; layer < 4; ++layer) {
    const int lj = layer >> 1;
    if ((layer & 1) == 0) {
      REP(0) phase_gemm<0>(wv_, p, p.hg, p.wab_t + (size_t)lj * 4224 * 1024, 33, smem, nullptr);
      REP(7) grid_bar(wv_, p.bar, xcc_, nloc_, nx_, gen);
      phase_gla<0, false>(wv_, p, lj, smem);
      REP(1) phase_sel(wv_, p, smem, p.bar + XCD_BAR_WORDS + lj);
      grid_bar(wv_, p.bar, xcc_, nloc_, nx_, gen);
      phase_gla<0, true>(wv_, p, lj, smem);
      REP(2) phase_att(wv_, p, smem, p.bar + XCD_BAR_WORDS + 32 + lj * 8, ahead_);
      grid_bar(wv_, p.bar, xcc_, nloc_, nx_, gen);
    } else {
      REP(0) phase_gemm<1>(wv_, p, p.hg, p.wcd_t + (size_t)lj * 3584 * 1024, 28, smem, nullptr);
      REP(7) grid_bar(wv_, p.bar, xcc_, nloc_, nx_, gen);
      phase_gla<1, false>(wv_, p, lj, smem);
      REP(5) phase_sb(wv_, p);
      grid_bar(wv_, p.bar, xcc_, nloc_, nx_, gen);
      phase_gla<1, true>(wv_, p, lj, smem);
      grid_bar(wv_, p.bar, xcc_, nloc_, nx_, gen);
    }
    phase_gemm<2>(wv_, p, p.hn, p.wout_t + (size_t)layer * 1024 * 1024, 8, smem, layer < 3 ? p.norm_g + (layer + 1) * 1024 : nullptr);
    REP(7) grid_bar(wv_, p.bar, xcc_, nloc_, nx_, gen);
  }
  phase_final(wv_, p);
}

extern "C" void kernel_launch(void* const* d_in, const int* in_sizes, int n_in, void* d_out, int out_size, void* d_ws, size_t ws_size,
                              hipStream_t stream) {
  static int grid_blocks = 0;
  if (!grid_blocks) {
    int dev = 0, cus = 0, per_cu = 0;
    hipGetDevice(&dev);
    hipDeviceGetAttribute(&cus, hipDeviceAttributeMultiprocessorCount, dev);
    hipOccupancyMaxActiveBlocksPerMultiprocessor(&per_cu, mega, NTHR, 0);
    if (per_cu > 2) per_cu = 2;
    grid_blocks = cus * per_cu;
  }
  Params p{};
  p.x = (const float*)d_in[0]; p.meta = (const float*)d_in[1]; p.rel_bias = (const float*)d_in[2];
  p.norm_g = (const float*)d_in[3]; p.final_g = (const float*)d_in[4]; p.w_in_ab = (const float*)d_in[5];
  p.gate_w2 = (const float*)d_in[6]; p.gate_b = (const float*)d_in[7]; p.w_out_ab = (const float*)d_in[8];
  p.w_in_cd = (const float*)d_in[9]; p.w_out_cd = (const float*)d_in[10];
  p.out = (float*)d_out;
  char* w = (char*)d_ws; size_t off = 0;
  auto take = [&](size_t bytes) { char* r = w + off; off += (bytes + 255) & ~(size_t)255; return r; };
  p.wab_t = (u16*)take((size_t)2 * 4224 * 1024 * 2);
  p.wcd_t = (u16*)take((size_t)2 * 3584 * 1024 * 2);
  p.wout_t = (u16*)take((size_t)4 * 1024 * 1024 * 2);
  p.hn = (u16*)take((size_t)NROWS * 1024 * 2);
  p.proj = (u16*)take((size_t)NROWS * LD_CD * 2);
  p.kc = (u16*)take((size_t)NB * 8 * P * 64 * 2);
  p.vc = (u16*)take((size_t)NB * 8 * P * 64 * 2);
  p.ikc = (u16*)take((size_t)NROWS * 64 * 2);
  p.runc = (float*)take((size_t)16 * NRUN * 8192 * 4);
  p.rund = (float*)take((size_t)16 * NRUN * 64 * 4);
  p.tcos = (float*)take((size_t)P * 32 * 4);
  p.tsin = (float*)take((size_t)P * 32 * 4);
  p.hmeta = (float*)take((size_t)NB * 16 * 1024 * 4);
  p.idx = (u16*)take((size_t)NROWS * 256 * 2);
  p.vt = p.kc;
  p.hg = (u16*)take((size_t)NROWS * 1024 * 2);
  p.ss = (float*)take((size_t)NROWS * 16 * 4);
  p.bar = (unsigned*)take(16384);
  hipMemsetAsync(p.bar, 0, 16384, stream);
  if (off > ws_size) { fprintf(stderr, "workspace too small: need %zu have %zu\n", off, ws_size); }
  void* args[] = {&p};
  hipError_t e = hipLaunchCooperativeKernel((void*)mega, dim3(grid_blocks), dim3(NTHR), args, 0, stream);
  if (e != hipSuccess) fprintf(stderr, "cooperative launch failed: %s (grid %d)\n", hipGetErrorString(e), grid_blocks);
}
```
